# Optimizing an MI355X kernel written in HIP

```python
import math
import jax, jax.numpy as jnp
from jax import lax
import numpy as np

D_MODEL = 2048
BATCH = 1
SEQ = 8192
DEPTH = 1
DEC_BATCH = 128
DEC_SEQ = 4
PAST_LEN = 2048
PAGE_SIZE = 128

N_HEADS = 16
KV_HEADS = 4
HEAD_DIM = D_MODEL // N_HEADS
IDX_HEADS = 16
IDX_DIM = 64
TOPK_MAX = 256
Q_BLOCK = 128
D_INNER = 2 * D_MODEL
SSM_HEAD_DIM = 64
SSM_HEADS = D_INNER // SSM_HEAD_DIM
SSM_GROUPS = 8
D_STATE = 128
CONV_W = 4
CONV_DIM = D_INNER + 2 * SSM_GROUPS * D_STATE
SSD_CHUNK = 128
D_FF = 4 * D_MODEL
ROPE_THETA = 10000.0
EPS = 1e-6
SPLITS = (N_HEADS * HEAD_DIM, KV_HEADS * HEAD_DIM, KV_HEADS * HEAD_DIM, IDX_HEADS * IDX_DIM, IDX_DIM, IDX_HEADS, D_INNER, CONV_DIM, SSM_HEADS, D_MODEL, D_MODEL)
IN_COLS = sum(SPLITS)

kernel_name = 'hybrid_dsa_ssd_gated_decode_step'


def _rms(xf):
    return xf * lax.rsqrt(jnp.mean(xf * xf, axis=-1, keepdims=True) + EPS)


def rmsnorm(x, g):
    return (_rms(x.astype(jnp.float32)) * g.astype(jnp.float32)).astype(x.dtype)


def layernorm(x, g, b):
    xf = x.astype(jnp.float32)
    xc = xf - jnp.mean(xf, axis=-1, keepdims=True)
    y = xc * lax.rsqrt(jnp.mean(xc * xc, axis=-1, keepdims=True) + EPS)
    return (y * g.astype(jnp.float32) + b.astype(jnp.float32)).astype(x.dtype)


def rope(x, pos):
    half = x.shape[-1] // 2
    inv = ROPE_THETA ** (-jnp.arange(half, dtype=jnp.float32) / half)
    ang = pos.astype(jnp.float32)[:, None] * inv[None, :]
    cos = jnp.cos(ang)[None, :, None, :]
    sin = jnp.sin(ang)[None, :, None, :]
    xf = x.astype(jnp.float32)
    x1, x2 = xf[..., :half], xf[..., half:]
    return jnp.concatenate([x1 * cos - x2 * sin, x2 * cos + x1 * sin], axis=-1).astype(x.dtype)


def gather_rows(rows, idx):
    return jax.vmap(lambda r, i: r[i])(rows, idx)


def mixer_inputs(x, pos, norm_mix_g, w_in, q_norm_g, k_norm_g, idx_ln_g, idx_ln_b):
    b, t = x.shape[:2]
    proj = rmsnorm(x, norm_mix_g) @ w_in
    cuts = [int(c) for c in np.cumsum(SPLITS)[:-1]]
    q, k, v, iq, ik, iw, z, xbc, dt, ga, gb = jnp.split(proj, cuts, axis=-1)
    q = rope(rmsnorm(q.reshape(b, t, N_HEADS, HEAD_DIM), q_norm_g), pos)
    k = rope(rmsnorm(k.reshape(b, t, KV_HEADS, HEAD_DIM), k_norm_g), pos)
    v = v.reshape(b, t, KV_HEADS, HEAD_DIM)
    iq = rope(iq.reshape(b, t, IDX_HEADS, IDX_DIM), pos)
    ik = rope(layernorm(ik, idx_ln_g, idx_ln_b)[:, :, None, :], pos)[:, :, 0, :]
    return q, k, v, iq, ik, iw, z, xbc, dt, ga, gb


def index_scores(iq, iw, ik, mask):
    dots = jnp.einsum('bthd,bsd->bths', iq.astype(jnp.float32), ik.astype(jnp.float32))
    wts = iw.astype(jnp.float32) * (IDX_HEADS ** -0.5 * IDX_DIM ** -0.5)
    score = jnp.einsum('bths,bth->bts', jax.nn.relu(dots), wts)
    return jnp.where(mask, score, -jnp.inf)


def sparse_attend(q, k_sel, v_sel, valid):
    b, t = q.shape[:2]
    qg = q.reshape(b, t, KV_HEADS, N_HEADS // KV_HEADS, HEAD_DIM).astype(jnp.float32)
    s = jnp.einsum('btgrd,btkgd->btgrk', qg, k_sel.astype(jnp.float32)) * (HEAD_DIM ** -0.5)
    s = jnp.where(valid[:, :, None, None, :], s, -jnp.inf)
    p = jax.nn.softmax(s, axis=-1)
    o = jnp.einsum('btgrk,btkgd->btgrd', p, v_sel.astype(jnp.float32))
    return o.reshape(b, t, N_HEADS * HEAD_DIM).astype(q.dtype)


def prompt_attention(q, k, v, iq, ik, iw):
    b, L = q.shape[:2]
    topk = min(TOPK_MAX, L // 4)
    nblk = L // Q_BLOCK

    def blocks(a):
        return jnp.moveaxis(a.reshape((b, nblk, Q_BLOCK) + a.shape[2:]), 1, 0)

    qpos = jnp.arange(L).reshape(nblk, Q_BLOCK)
    kpos = jnp.arange(L)

    def one_block(args):
        qb, iqb, iwb, pb = args
        mask = (kpos[None, :] <= pb[:, None])[None]
        _, sel = lax.top_k(index_scores(iqb, iwb, ik, mask), topk)
        valid = sel <= pb[None, :, None]
        return sparse_attend(qb, gather_rows(k, sel), gather_rows(v, sel), valid)

    out = lax.map(one_block, (blocks(q), blocks(iq), blocks(iw), qpos))
    return jnp.moveaxis(out, 0, 1).reshape(b, L, N_HEADS * HEAD_DIM)


def sample_attention(q, k_new, v_new, iq, ik_new, iw, cache_k, cache_v, cache_idx_k, page_table):
    db, t = q.shape[:2]
    L = PAST_LEN + t
    topk = min(TOPK_MAX, L // 4)
    ik_past = cache_idx_k[page_table].reshape(db, PAST_LEN, IDX_DIM)
    ik_all = jnp.concatenate([ik_past.astype(ik_new.dtype), ik_new], axis=1)
    qpos = PAST_LEN + jnp.arange(t)
    mask = (jnp.arange(L)[None, :] <= qpos[:, None])[None]
    _, sel = lax.top_k(index_scores(iq, iw, ik_all, mask), topk)
    valid = sel <= qpos[None, :, None]
    from_past = (sel < PAST_LEN)[..., None, None]
    pidx = jnp.minimum(sel, PAST_LEN - 1)
    phys = jnp.take_along_axis(page_table, (pidx // PAGE_SIZE).reshape(db, -1), axis=1).reshape(sel.shape)
    off = pidx % PAGE_SIZE
    nidx = jnp.clip(sel - PAST_LEN, 0, t - 1)
    k_sel = jnp.where(from_past, cache_k[phys, off].astype(k_new.dtype), gather_rows(k_new, nidx))
    v_sel = jnp.where(from_past, cache_v[phys, off].astype(v_new.dtype), gather_rows(v_new, nidx))
    return sparse_attend(q, k_sel, v_sel, valid)


def ssd_scan(x, dt, a, bm, cm, init):
    f32 = jnp.float32
    b, T = x.shape[:2]
    Q = math.gcd(T, SSD_CHUNK)
    c = T // Q
    G, R, P, N = SSM_GROUPS, SSM_HEADS // SSM_GROUPS, SSM_HEAD_DIM, D_STATE
    xdt = (x.astype(f32) * dt[..., None]).reshape(b, c, Q, G, R, P)
    da = jnp.moveaxis((dt * a).reshape(b, c, Q, G, R), 2, -1)
    cs = jnp.cumsum(da, axis=-1)
    bc = bm.astype(f32).reshape(b, c, Q, G, N)
    cc = cm.astype(f32).reshape(b, c, Q, G, N)
    causal = jnp.tril(jnp.ones((Q, Q), bool))
    lmat = jnp.exp(jnp.where(causal, cs[..., :, None] - cs[..., None, :], -jnp.inf))
    cb = jnp.einsum('bclgn,bcsgn->bcgls', cc, bc)
    y_diag = jnp.einsum('bcgrls,bcsgrp->bclgrp', cb[:, :, :, None] * lmat, xdt)
    decay_end = jnp.moveaxis(jnp.exp(cs[..., -1:] - cs), -1, 2)[..., None]
    chunk_states = jnp.einsum('bcsgn,bcsgrp->bcgrpn', bc, xdt * decay_end)
    states_all = jnp.concatenate([init.astype(f32).reshape(b, 1, G, R, P, N), chunk_states], axis=1)
    tot = jnp.moveaxis(cs[..., -1], 1, -1)
    cs_chunk = jnp.concatenate([jnp.zeros((b, G, R, 1), f32), jnp.cumsum(tot, axis=-1)], axis=-1)
    causal_c = jnp.tril(jnp.ones((c + 1, c + 1), bool))
    decay_chunk = jnp.exp(jnp.where(causal_c, cs_chunk[..., :, None] - cs_chunk[..., None, :], -jnp.inf))
    new_states = jnp.einsum('bgrzc,bcgrpn->bzgrpn', decay_chunk, states_all)
    states_in, final = new_states[:, :-1], new_states[:, -1]
    y_off = jnp.einsum('bclgn,bcgrpn->bclgrp', cc, states_in) * jnp.moveaxis(jnp.exp(cs), -1, 2)[..., None]
    y = (y_diag + y_off).reshape(b, T, SSM_HEADS, P)
    return y, final.reshape(b, SSM_HEADS, P, N)


def ssm_branch(z, xbc_raw, dt_raw, conv_state, ssm_state, conv_w, conv_b, dt_bias, a_log, d_skip, ssm_norm_g):
    f32 = jnp.float32
    b, t = xbc_raw.shape[:2]
    xpad = jnp.concatenate([conv_state.astype(xbc_raw.dtype), xbc_raw], axis=1)
    acc = xpad[:, 0:t] * conv_w[0]
    for i in range(1, CONV_W):
        acc = acc + xpad[:, i:i + t] * conv_w[i]
    xbc = jax.nn.silu(acc + conv_b)
    xs, bm, cm = jnp.split(xbc, [D_INNER, D_INNER + SSM_GROUPS * D_STATE], axis=-1)
    xs = xs.reshape(b, t, SSM_HEADS, SSM_HEAD_DIM)
    bm = bm.reshape(b, t, SSM_GROUPS, D_STATE)
    cm = cm.reshape(b, t, SSM_GROUPS, D_STATE)
    dt = jax.nn.softplus(dt_raw.astype(f32) + dt_bias.astype(f32))
    a = -jnp.exp(a_log.astype(f32))
    y, final = ssd_scan(xs, dt, a, bm, cm, ssm_state)
    y = y + d_skip.astype(f32)[:, None] * xs.astype(f32)
    y = y.reshape(b, t, D_INNER) * jax.nn.silu(z.astype(f32))
    y = _rms(y.reshape(b, t, SSM_GROUPS, D_INNER // SSM_GROUPS)).reshape(b, t, D_INNER) * ssm_norm_g.astype(f32)
    return y.astype(z.dtype), xpad[:, t:], final.astype(ssm_state.dtype)


def merge_and_mlp(x, attn_o, ssm_o, ga, gb, w_proj_attn, w_proj_ssm, w_out, norm_mlp_g, w_up, w_down):
    mixed = jax.nn.sigmoid(ga) * (attn_o @ w_proj_attn) + jax.nn.sigmoid(gb) * (ssm_o @ w_proj_ssm)
    h = x + mixed @ w_out
    u = rmsnorm(h, norm_mlp_g) @ w_up
    return h + jnp.square(jax.nn.relu(u)) @ w_down


def setup_inputs(seed: int = 0) -> dict:
    key = jax.random.key(seed)
    ks = jax.random.split(key, 28)
    f32 = jnp.float32
    n_pages = PAST_LEN // PAGE_SIZE
    n_used = DEC_BATCH * n_pages
    n_pool = n_used + max(1, n_used // 4)

    def nrm(k, shape, s):
        return s * jax.random.normal(k, shape, f32)

    page_table = jax.random.permutation(ks[0], n_pool)[:n_used].reshape(DEC_BATCH, n_pages).astype(jnp.int32)
    dt0 = jnp.exp(jax.random.uniform(ks[1], (DEPTH, SSM_HEADS), f32, math.log(1e-3), math.log(1e-1)))
    dt_bias = dt0 + jnp.log(-jnp.expm1(-dt0))
    a_log = jnp.log(jax.random.uniform(ks[2], (DEPTH, SSM_HEADS), f32, 1.0, 16.0))
    return {
        'x_prompt': nrm(ks[3], (BATCH, SEQ, D_MODEL), 1.0),
        'x_sample': nrm(ks[4], (DEC_BATCH, DEC_SEQ, D_MODEL), 1.0),
        'cache_k': nrm(ks[5], (DEPTH, n_pool, PAGE_SIZE, KV_HEADS, HEAD_DIM), 1.0),
        'cache_v': nrm(ks[6], (DEPTH, n_pool, PAGE_SIZE, KV_HEADS, HEAD_DIM), 1.0),
        'cache_idx_k': nrm(ks[7], (DEPTH, n_pool, PAGE_SIZE, IDX_DIM), 1.0),
        'state_conv': nrm(ks[8], (DEPTH, DEC_BATCH, CONV_W - 1, CONV_DIM), 1.0),
        'state_ssm': nrm(ks[9], (DEPTH, DEC_BATCH, SSM_HEADS, SSM_HEAD_DIM, D_STATE), 0.2),
        'page_table': page_table,
        'norm_mix_g': 1.0 + nrm(ks[10], (DEPTH, D_MODEL), 0.02),
        'w_in': nrm(ks[11], (DEPTH, D_MODEL, IN_COLS), D_MODEL ** -0.5),
        'q_norm_g': 1.0 + nrm(ks[12], (DEPTH, HEAD_DIM), 0.02),
        'k_norm_g': 1.0 + nrm(ks[13], (DEPTH, HEAD_DIM), 0.02),
        'idx_ln_g': 1.0 + nrm(ks[14], (DEPTH, IDX_DIM), 0.02),
        'idx_ln_b': nrm(ks[15], (DEPTH, IDX_DIM), 0.02),
        'conv_w': nrm(ks[16], (DEPTH, CONV_W, CONV_DIM), CONV_W ** -0.5),
        'conv_b': nrm(ks[17], (DEPTH, CONV_DIM), 0.01),
        'dt_bias': dt_bias,
        'a_log': a_log,
        'd_skip': 1.0 + nrm(ks[18], (DEPTH, SSM_HEADS), 0.1),
        'ssm_norm_g': 1.0 + nrm(ks[19], (DEPTH, D_INNER), 0.02),
        'w_proj_attn': nrm(ks[20], (DEPTH, N_HEADS * HEAD_DIM, D_MODEL), (N_HEADS * HEAD_DIM) ** -0.5),
        'w_proj_ssm': nrm(ks[21], (DEPTH, D_INNER, D_MODEL), D_INNER ** -0.5),
        'w_out': nrm(ks[22], (DEPTH, D_MODEL, D_MODEL), D_MODEL ** -0.5),
        'norm_mlp_g': 1.0 + nrm(ks[23], (DEPTH, D_MODEL), 0.02),
        'w_up': nrm(ks[24], (DEPTH, D_MODEL, D_FF), D_MODEL ** -0.5),
        'w_down': nrm(ks[25], (DEPTH, D_FF, D_MODEL), D_FF ** -0.5),
    }


def reference(x_prompt, x_sample, cache_k, cache_v, cache_idx_k, state_conv, state_ssm, page_table,
              norm_mix_g, w_in, q_norm_g, k_norm_g, idx_ln_g, idx_ln_b, conv_w, conv_b, dt_bias, a_log,
              d_skip, ssm_norm_g, w_proj_attn, w_proj_ssm, w_out, norm_mlp_g, w_up, w_down):
    b_p, seq = x_prompt.shape[:2]
    pos_p = jnp.arange(seq)
    pos_s = PAST_LEN + jnp.arange(x_sample.shape[1])
    hp, hs = x_prompt, x_sample
    kp, vp, ikp, cvp, ssp = [], [], [], [], []
    ks_, vs_, iks, cvs, sss = [], [], [], [], []
    for l in range(DEPTH):
        q, k, v, iq, ik, iw, z, xbc, dt, ga, gb = mixer_inputs(hp, pos_p, norm_mix_g[l], w_in[l], q_norm_g[l], k_norm_g[l], idx_ln_g[l], idx_ln_b[l])
        attn = prompt_attention(q, k, v, iq, ik, iw)
        zero_conv = jnp.zeros((b_p, CONV_W - 1, CONV_DIM), hp.dtype)
        zero_ssm = jnp.zeros((b_p, SSM_HEADS, SSM_HEAD_DIM, D_STATE), hp.dtype)
        ssm, conv_new, ssm_new = ssm_branch(z, xbc, dt, zero_conv, zero_ssm, conv_w[l], conv_b[l], dt_bias[l], a_log[l], d_skip[l], ssm_norm_g[l])
        hp = merge_and_mlp(hp, attn, ssm, ga, gb, w_proj_attn[l], w_proj_ssm[l], w_out[l], norm_mlp_g[l], w_up[l], w_down[l])
        kp.append(k); vp.append(v); ikp.append(ik); cvp.append(conv_new); ssp.append(ssm_new)
        q, k, v, iq, ik, iw, z, xbc, dt, ga, gb = mixer_inputs(hs, pos_s, norm_mix_g[l], w_in[l], q_norm_g[l], k_norm_g[l], idx_ln_g[l], idx_ln_b[l])
        attn = sample_attention(q, k, v, iq, ik, iw, cache_k[l], cache_v[l], cache_idx_k[l], page_table)
        ssm, conv_new, ssm_new = ssm_branch(z, xbc, dt, state_conv[l], state_ssm[l], conv_w[l], conv_b[l], dt_bias[l], a_log[l], d_skip[l], ssm_norm_g[l])
        hs = merge_and_mlp(hs, attn, ssm, ga, gb, w_proj_attn[l], w_proj_ssm[l], w_out[l], norm_mlp_g[l], w_up[l], w_down[l])
        ks_.append(k); vs_.append(v); iks.append(ik); cvs.append(conv_new); sss.append(ssm_new)
    return (hp, hs,
            jnp.stack(kp), jnp.stack(vp), jnp.stack(ikp), jnp.stack(cvp), jnp.stack(ssp),
            jnp.stack(ks_), jnp.stack(vs_), jnp.stack(iks), jnp.stack(cvs), jnp.stack(sss))
```

```cpp
#include <hip/hip_runtime.h>
#include <cstdio>
#include <cstdint>
#define ONE_LAUNCH 1
namespace pg8 {
#define PG8_LAS __attribute__((address_space(3)))
typedef unsigned short bf16_t;
typedef short bf16x8 __attribute__((ext_vector_type(8)));
typedef float f32x4 __attribute__((ext_vector_type(4)));
typedef unsigned u32x4 __attribute__((ext_vector_type(4)));
constexpr int BM = 256, BK = 64, HALF = 128, HTB = HALF * BK * 2  , STAGE_BYTES = 8 * HTB, NXCD = 8, WGM = 8;

__host__ __device__ __forceinline__ int lds_byte(int r, int c) { const int st = (r >> 4) * 2 + (c >> 5), rr = r & 15, cc = c & 31, ob = rr * 64 + cc * 2; return st * 1024 + (ob ^ (((ob >> 9) & 1) << 5)); }
__host__ __device__ __forceinline__ void stage_rc(int b, int& R, int& C) { const int st = b / 1024, sb = b % 1024, swz = sb ^ (((sb >> 9) & 1) << 5); R = (st >> 1) * 16 + swz / 64; C = (st & 1) * 32 + (swz % 64) / 2; }
__host__ __device__ __forceinline__ int perm32(int rho) { const int n = rho >> 4, i = rho & 15; return 8 * (i >> 2) + 4 * n + (i & 3); }

struct Unit { int pm, pn; };
struct Gemm { const bf16_t* A; const bf16_t* Bt; int M, N, K; };

struct StaticOrder {
    int nM, nN, nwg, G, c;
    __host__ __device__ void init(int M, int N, int G_, int c_) { nM = M / BM; nN = N / BM; nwg = nM * nN; G = G_; c = c_; }
    __host__ __device__ bool next(int i, Unit& u) const {
        const long L = (long)i * G + c; if (L >= nwg) return false;
        int wgid = (int)L; { const int q = nwg / NXCD, r = nwg % NXCD, xcd = wgid % NXCD, off = wgid / NXCD; wgid = (xcd < r ? xcd * (q + 1) : r * (q + 1) + (xcd - r) * q) + off; }
        const int nig = WGM * nN, gid = wgid / nig, fm = gid * WGM, gsz = (nM - fm) < WGM ? (nM - fm) : WGM;
        u.pm = fm + ((wgid % nig) % gsz); u.pn = (wgid % nig) / gsz; return true;
    }
    __device__ __forceinline__ void a_ready(const Unit&) const {}
    __device__ __forceinline__ void done(const Unit&) const {}
};
__device__ __forceinline__ unsigned cvt_pk_bf16(float lo, float hi) { unsigned r; asm volatile("v_cvt_pk_bf16_f32 %0, %1, %2" : "=v"(r) : "v"(lo), "v"(hi)); return r; }
typedef float f32x2 __attribute__((ext_vector_type(2)));
template <class Epi, class Sched, bool ALIGN_EPI = false, bool SP2 = false>
__device__ __forceinline__ void gemm_phase(PG8_LAS unsigned char* lds, const Gemm g, const Sched& S, const Epi& E) {
    const int tid = threadIdx.x, wid = __builtin_amdgcn_readfirstlane(tid >> 6), lane = tid & 63, wr = wid >> 2, wc = wid & 3, fr = lane & 15, fq = lane >> 4;
    const int K = g.K, nt = K / BK;
    unsigned voffA[2], voffB[2];
#pragma unroll
    for (int i = 0; i < 2; ++i) { int R, C; stage_rc(tid * 16 + i * 8192, R, C); const int Rb = Epi::PERM ? ((R & ~31) + perm32(R & 31)) : R;
        voffA[i] = (unsigned)(R * K + C) * 2u; voffB[i] = (unsigned)(Rb * K + C) * 2u; }
    const size_t kstep = (size_t)(BK * 2);
    const size_t hstep = (size_t)HALF * K * 2;
    const size_t tstep = 2 * hstep;
    const unsigned ldsw = (unsigned)wid * 1024u;
    const int aoff = lds_byte(wr * 64 + fr, fq * 8), boff = lds_byte(wc * 32 + fr, fq * 8);
#define PG8_SA(b, h) (((b) * 2 + (h)) * HTB)
#define PG8_SB(b, h) ((4 + (b) * 2 + (h)) * HTB)
#define PG8_STAGE(bufoff, gbase, voff) do { _Pragma("unroll") for (int _i = 0; _i < 2; ++_i) \
        __builtin_amdgcn_global_load_lds((const unsigned*)((const char*)(gbase) + (voff)[_i]), (PG8_LAS unsigned*)(lds + (bufoff) + ldsw + _i * 8192), 16, 0, 0); } while (0)
#define PG8_LDA(dst, b, h) do { _Pragma("unroll") for (int m = 0; m < 4; ++m) _Pragma("unroll") for (int k = 0; k < 2; ++k) dst[m][k] = *(const PG8_LAS bf16x8*)(lds + PG8_SA(b, h) + aoff + m * 2048 + k * 1024); } while (0)
#define PG8_LDB(dst, b, h) do { _Pragma("unroll") for (int n = 0; n < 2; ++n) _Pragma("unroll") for (int k = 0; k < 2; ++k) dst[n][k] = *(const PG8_LAS bf16x8*)(lds + PG8_SB(b, h) + boff + n * 2048 + k * 1024); } while (0)
#define PG8_MMA(ai, bj, At, Bt) do { __builtin_amdgcn_s_setprio(1); _Pragma("unroll") for (int m = 0; m < 4; ++m) _Pragma("unroll") for (int n = 0; n < 2; ++n) _Pragma("unroll") for (int k = 0; k < 2; ++k) \
        acc[ai][bj][m][n] = __builtin_amdgcn_mfma_f32_16x16x32_bf16(Bt[n][k], At[m][k], acc[ai][bj][m][n], 0, 0, 0); __builtin_amdgcn_s_setprio(0); } while (0)
#define PG8_WAIT_V(n) asm volatile("s_waitcnt vmcnt(" #n ")" ::: "memory")
#define PG8_WAIT_L(n) asm volatile("s_waitcnt lgkmcnt(" #n ")" ::: "memory")
#define PG8_BAR __builtin_amdgcn_s_barrier()
#define PG8_SCHED __builtin_amdgcn_sched_barrier(0)
    Unit cur, nxt; int ui = 0;
    if (!S.next(0, cur)) return;
    f32x4 acc[2][2][4][2];
#pragma unroll
    for (int a = 0; a < 2; ++a)
#pragma unroll
        for (int b = 0; b < 2; ++b)
#pragma unroll
            for (int m = 0; m < 4; ++m)
#pragma unroll
                for (int n = 0; n < 2; ++n) acc[a][b][m][n] = (f32x4){0.f, 0.f, 0.f, 0.f};
    bf16x8 At[4][2], B0[2][2], B1[2][2];
    const char* cA = (const char*)g.A + (size_t)cur.pm * tstep; const char* cB = (const char*)g.Bt + (size_t)cur.pn * tstep;
    S.a_ready(cur);
    if constexpr (SP2) {
        PG8_STAGE(PG8_SB(0, 0), cB, voffB); PG8_STAGE(PG8_SB(0, 1), cB + hstep, voffB); PG8_STAGE(PG8_SA(0, 0), cA, voffA); PG8_STAGE(PG8_SA(0, 1), cA + hstep, voffA);
        if (wr == 1) PG8_BAR;
        PG8_WAIT_V(2); PG8_BAR;
        PG8_STAGE(PG8_SB(1, 0), cB + kstep, voffB); PG8_STAGE(PG8_SA(1, 0), cA + kstep, voffA); PG8_STAGE(PG8_SB(1, 1), cB + hstep + kstep, voffB);
        PG8_WAIT_V(6); PG8_BAR;
    } else {
        PG8_STAGE(PG8_SB(0, 0), cB, voffB); PG8_STAGE(PG8_SA(0, 0), cA, voffA); PG8_STAGE(PG8_SB(0, 1), cB + hstep, voffB); PG8_STAGE(PG8_SA(0, 1), cA + hstep, voffA);
        if (wr == 1) PG8_BAR;
        PG8_WAIT_V(4); PG8_BAR;
        PG8_STAGE(PG8_SB(1, 0), cB + kstep, voffB); PG8_STAGE(PG8_SA(1, 0), cA + kstep, voffA); PG8_STAGE(PG8_SB(1, 1), cB + hstep + kstep, voffB);
        PG8_WAIT_V(6); PG8_BAR;
    }
    for (;;) {
        const bool has_next = S.next(ui + 1, nxt);
        const char* nA = has_next ? (const char*)g.A + (size_t)nxt.pm * tstep : cA; const char* nB = has_next ? (const char*)g.Bt + (size_t)nxt.pn * tstep : cB;
        for (int t = 0; t < nt; t += 2) {
            const bool last = (t == nt - 2);
            const char* a1 = cA + (size_t)(t + 1) * kstep;
            const char* a2 = last ? nA : cA + (size_t)(t + 2) * kstep; const char* b2 = last ? nB : cB + (size_t)(t + 2) * kstep;
            const char* a3 = a2 + kstep; const char* b3 = b2 + kstep;
            if (last && has_next) S.a_ready(nxt);
            if constexpr (SP2) {
            PG8_LDB(B0, 0, 0); PG8_LDB(B1, 0, 1); PG8_SCHED; PG8_LDA(At, 0, 0); PG8_STAGE(PG8_SA(1, 1), a1 + hstep, voffA);
            PG8_WAIT_V(8); PG8_WAIT_L(0); PG8_BAR; PG8_MMA(0, 0, At, B0); PG8_MMA(0, 1, At, B1); PG8_BAR; PG8_SCHED;
            PG8_LDA(At, 0, 1); PG8_STAGE(PG8_SB(0, 0), b2, voffB); PG8_STAGE(PG8_SB(0, 1), b2 + hstep, voffB); PG8_STAGE(PG8_SA(0, 0), a2, voffA);
            PG8_WAIT_V(8); PG8_WAIT_L(0); PG8_BAR; PG8_MMA(1, 0, At, B0); PG8_MMA(1, 1, At, B1); PG8_BAR; PG8_SCHED;
            PG8_LDB(B0, 1, 0); PG8_LDB(B1, 1, 1); PG8_SCHED; PG8_LDA(At, 1, 0); PG8_STAGE(PG8_SA(0, 1), a2 + hstep, voffA);
            PG8_WAIT_V(8); PG8_WAIT_L(0); PG8_BAR; PG8_MMA(0, 0, At, B0); PG8_MMA(0, 1, At, B1); PG8_BAR; PG8_SCHED;
            PG8_LDA(At, 1, 1); PG8_STAGE(PG8_SB(1, 0), b3, voffB); PG8_STAGE(PG8_SB(1, 1), b3 + hstep, voffB); PG8_STAGE(PG8_SA(1, 0), a3, voffA);
            PG8_WAIT_V(8); PG8_WAIT_L(0); PG8_BAR; PG8_MMA(1, 0, At, B0); PG8_MMA(1, 1, At, B1); PG8_BAR; PG8_SCHED;
            } else {
            PG8_LDB(B0, 0, 0); PG8_SCHED; PG8_LDA(At, 0, 0); PG8_STAGE(PG8_SA(1, 1), a1 + hstep, voffA);
            PG8_WAIT_L(8); PG8_BAR; PG8_WAIT_L(0); PG8_MMA(0, 0, At, B0); PG8_BAR; PG8_SCHED;
            PG8_LDB(B1, 0, 1); PG8_STAGE(PG8_SB(0, 0), b2, voffB);
            PG8_BAR; PG8_WAIT_L(0); PG8_MMA(0, 1, At, B1); PG8_BAR;
            PG8_LDA(At, 0, 1); PG8_STAGE(PG8_SA(0, 0), a2, voffA);
            PG8_BAR; PG8_WAIT_L(0); PG8_MMA(1, 0, At, B0); PG8_BAR; PG8_SCHED;
            PG8_STAGE(PG8_SB(0, 1), b2 + hstep, voffB);
            PG8_WAIT_V(6); PG8_BAR; PG8_MMA(1, 1, At, B1); PG8_BAR;
            PG8_LDB(B0, 1, 0); PG8_SCHED; PG8_LDA(At, 1, 0); PG8_STAGE(PG8_SA(0, 1), a2 + hstep, voffA);
            PG8_WAIT_L(8); PG8_BAR; PG8_WAIT_L(0); PG8_MMA(0, 0, At, B0); PG8_BAR; PG8_SCHED;
            PG8_LDB(B1, 1, 1); PG8_STAGE(PG8_SB(1, 0), b3, voffB);
            PG8_BAR; PG8_WAIT_L(0); PG8_MMA(0, 1, At, B1); PG8_BAR;
            PG8_LDA(At, 1, 1); PG8_STAGE(PG8_SA(1, 0), a3, voffA);
            PG8_BAR; PG8_WAIT_L(0); PG8_MMA(1, 0, At, B0); PG8_BAR; PG8_SCHED;
            PG8_STAGE(PG8_SB(1, 1), b3 + hstep, voffB);
            PG8_WAIT_V(6); PG8_BAR; PG8_MMA(1, 1, At, B1); PG8_BAR;
            }
        }
        if constexpr (ALIGN_EPI) { if (wr == 0) PG8_BAR; }
        if constexpr (!Epi::AFTER_DRAIN) { E(acc, cur, wr, wc, fr, fq); S.done(cur); }
        if (!has_next) break;
#pragma unroll
        for (int a = 0; a < 2; ++a)
#pragma unroll
            for (int b = 0; b < 2; ++b)
#pragma unroll
                for (int m = 0; m < 4; ++m)
#pragma unroll
                    for (int n = 0; n < 2; ++n) acc[a][b][m][n] = (f32x4){0.f, 0.f, 0.f, 0.f};
        cur = nxt; cA = nA; cB = nB; ++ui;
        if constexpr (ALIGN_EPI) { if (wr == 1) PG8_BAR; }
    }
    PG8_WAIT_V(0);
    if constexpr (!ALIGN_EPI) { if (wr == 0) PG8_BAR; }
    PG8_BAR;
    if constexpr (Epi::AFTER_DRAIN) { E.fused(acc, cur, wr, wc, fr, fq, lds, wid, lane); S.done(cur); }
#undef PG8_SA
#undef PG8_SB
#undef PG8_STAGE
#undef PG8_LDA
#undef PG8_LDB
#undef PG8_MMA
#undef PG8_WAIT_V
#undef PG8_WAIT_L
#undef PG8_BAR
#undef PG8_SCHED
}
}

#define GAS __attribute__((address_space(1)))
#define LAS __attribute__((address_space(3)))
typedef unsigned short bf16;
typedef unsigned v4u __attribute__((ext_vector_type(4)));
typedef unsigned v2u __attribute__((ext_vector_type(2)));
typedef float f32x4 __attribute__((ext_vector_type(4)));
typedef float f32x2 __attribute__((ext_vector_type(2)));
typedef float f32x16 __attribute__((ext_vector_type(16)));
typedef short bf16x8 __attribute__((ext_vector_type(8)));
typedef short v4i16_t __attribute__((ext_vector_type(4)));

constexpr int NWAVES = 8, NTHR = 512;
constexpr int DM = 2048, TP = 8192, TS = 512, MT = TP + TS, NB = 128, DSEQ = 4, PAST = 2048;
constexpr int NIN_SRC = 18576, NIN = 18688;
constexpr int C_Q = 0, C_K = 2048, C_V = 2560, C_IQ = 3072, C_IK = 4096, C_DT = 4160, C_IW = 4224, C_Z = 4352, C_XBC = 8448, C_GA = 14592, C_GB = 16640;
constexpr int PF_LD = 1280, PF_K = 0, PF_V = 512, PF_IK = 1024, PF_DT = 1088, PF_IW = 1152;
constexpr int DI = 4096, CONVD = 6144, DFF = 8192, NPOOLROWS = 2560 * 128;
constexpr int SCS_LD = 2112, NKS = PAST + DSEQ;
constexpr float EPS = 1e-6f;
constexpr size_t O_Y = 0, O_KP = 17825792, O_VP = 22020096, O_IKP = 26214400, O_CVP = 26738688, O_SSP = 26757120,
                 O_KS = 27281408, O_VS = 27543552, O_IKS = 27805696, O_CVS = 27838464, O_SSS = 30197760, O_END = 97306624;
constexpr size_t MiB = 1u << 20;
constexpr size_t WS_CTL = 0, CTL_ZERO_BYTES = 1 * MiB;
constexpr size_t WS_WIN = 2 * MiB, WS_WPA = 76 * MiB, WS_WPS = 84 * MiB, WS_WOUT = 100 * MiB, WS_WUP = 108 * MiB, WS_WDN = 140 * MiB;
constexpr size_t WS_XN = 172 * MiB, WS_PROJ = 208 * MiB, WS_PF = 520 * MiB, WS_KB = 564 * MiB, WS_VB = 573 * MiB, WS_IKB = 582 * MiB, WS_IWB = 584 * MiB, WS_DTB = 585 * MiB;
constexpr size_t WS_XT = 588 * MiB  , WS_BROW = 652 * MiB  , WS_CROW = 668 * MiB  , WS_BT = 684 * MiB  , WS_XBS = 700 * MiB  ;
constexpr size_t WS_SC = 708 * MiB  , WS_SCS = 964 * MiB  , WS_SEL = 970 * MiB  , WS_CNT = 979 * MiB, WS_AO = 980 * MiB  ;
constexpr size_t WS_CS = 1016 * MiB  , WS_CSL = 1144 * MiB, WS_STIN = 1145 * MiB  , WS_SSMO = 1210 * MiB  ;
constexpr size_t WS_MIX32 = 1280 * MiB  , WS_MIXB = 1348 * MiB  , WS_H = 1384 * MiB  , WS_HN = 1452 * MiB  , WS_U = 1488 * MiB  , WS_END = 1626 * MiB;
constexpr int CW_BAR = 4096;
constexpr int LDS_BYTES = 147456, RING_BYTES = 131072, CTL_OFF = 139264, MISC_OFF = CTL_OFF + 320;

struct Params {
    const float* in[26]; float* out; unsigned char* ws; int ph_lo, ph_hi;
};

#define LDS_WAIT() asm volatile("s_waitcnt lgkmcnt(0)" ::: "memory")
#define VM_WAIT() asm volatile("s_waitcnt vmcnt(0)" ::: "memory")
__device__ __forceinline__ unsigned pk2(float lo, float hi) { return pg8::cvt_pk_bf16(lo, hi); }
__device__ __forceinline__ float bf_lo(unsigned w) { return __uint_as_float(w << 16); }
__device__ __forceinline__ float bf_hi(unsigned w) { return __uint_as_float(w & 0xffff0000u); }
__device__ __forceinline__ float bf1(bf16 b) { return __uint_as_float(((unsigned)b) << 16); }
__device__ __forceinline__ float sigmoidf_(float x) { return 1.f / (1.f + __expf(-x)); }
__device__ __forceinline__ float siluf_(float x) { return x / (1.f + __expf(-x)); }
__device__ __forceinline__ float wave_sum(float v) {
#pragma unroll
    for (int o = 1; o < 64; o <<= 1) v += __shfl_xor(v, o);
    return v;
}
__device__ __forceinline__ const float* xrow_ptr(const Params& p, int r) { return r < TP ? p.in[0] + (size_t)r * DM : p.in[1] + (size_t)(r - TP) * DM; }

struct EpiIn {
    static constexpr bool PERM = true, AFTER_DRAIN = false;
    bf16* P; float* F;
    __device__ __forceinline__ void operator()(const pg8::f32x4 (&acc)[2][2][4][2], const pg8::Unit& u, int wr, int wc, int fr, int fq) const {
        const int row0 = u.pm * 256 + wr * 64 + fr, pn = u.pn;
        const bool isf = (pn >= 8 && pn < 12) || pn == 16;
        if (isf) {
            const int fc = (pn == 16 ? 1024 : (pn - 8) * 256) + wc * 32 + 8 * fq;
#pragma unroll
            for (int ai = 0; ai < 2; ++ai)
#pragma unroll
                for (int m = 0; m < 4; ++m) { float* rp = F + (size_t)(row0 + ai * 128 + m * 16) * PF_LD + fc;
#pragma unroll
                    for (int bj = 0; bj < 2; ++bj) { *(f32x4*)(rp + bj * 128) = acc[ai][bj][m][0]; *(f32x4*)(rp + bj * 128 + 4) = acc[ai][bj][m][1]; } }
        } else {
            const int c0 = pn * 256 + wc * 32 + 8 * fq;
#pragma unroll
            for (int ai = 0; ai < 2; ++ai)
#pragma unroll
                for (int m = 0; m < 4; ++m) { bf16* rp = P + (size_t)(row0 + ai * 128 + m * 16) * NIN + c0;
#pragma unroll
                    for (int bj = 0; bj < 2; ++bj) { const f32x4 v0 = acc[ai][bj][m][0], v1 = acc[ai][bj][m][1];
                        v4u w; w.x = pk2(v0[0], v0[1]); w.y = pk2(v0[2], v0[3]); w.z = pk2(v1[0], v1[1]); w.w = pk2(v1[2], v1[3]);
                        *(v4u*)(rp + bj * 128) = w; } }
        }
    }
};
struct EpiPA {
    static constexpr bool PERM = true, AFTER_DRAIN = false;
    const bf16* P; float* MX;
    __device__ __forceinline__ void operator()(const pg8::f32x4 (&acc)[2][2][4][2], const pg8::Unit& u, int wr, int wc, int fr, int fq) const {
        const int row0 = u.pm * 256 + wr * 64 + fr, c0 = u.pn * 256 + wc * 32 + 8 * fq;
#pragma unroll
        for (int ai = 0; ai < 2; ++ai)
#pragma unroll
            for (int m = 0; m < 4; ++m) { const int row = row0 + ai * 128 + m * 16;
#pragma unroll
                for (int bj = 0; bj < 2; ++bj) { const int c = c0 + bj * 128;
                    const v4u g = *(const v4u*)(P + (size_t)row * NIN + C_GA + c);
                    const f32x4 v0 = acc[ai][bj][m][0], v1 = acc[ai][bj][m][1];
                    f32x4 o0, o1;
                    o0[0] = sigmoidf_(bf_lo(g.x)) * v0[0]; o0[1] = sigmoidf_(bf_hi(g.x)) * v0[1]; o0[2] = sigmoidf_(bf_lo(g.y)) * v0[2]; o0[3] = sigmoidf_(bf_hi(g.y)) * v0[3];
                    o1[0] = sigmoidf_(bf_lo(g.z)) * v1[0]; o1[1] = sigmoidf_(bf_hi(g.z)) * v1[1]; o1[2] = sigmoidf_(bf_lo(g.w)) * v1[2]; o1[3] = sigmoidf_(bf_hi(g.w)) * v1[3];
                    float* mp = MX + (size_t)row * DM + c; *(f32x4*)mp = o0; *(f32x4*)(mp + 4) = o1; } }
    }
};
struct EpiPS {
    static constexpr bool PERM = true, AFTER_DRAIN = false;
    const bf16* P; const float* MX; bf16* MB;
    __device__ __forceinline__ void operator()(const pg8::f32x4 (&acc)[2][2][4][2], const pg8::Unit& u, int wr, int wc, int fr, int fq) const {
        const int row0 = u.pm * 256 + wr * 64 + fr, c0 = u.pn * 256 + wc * 32 + 8 * fq;
#pragma unroll
        for (int ai = 0; ai < 2; ++ai)
#pragma unroll
            for (int m = 0; m < 4; ++m) { const int row = row0 + ai * 128 + m * 16;
#pragma unroll
                for (int bj = 0; bj < 2; ++bj) { const int c = c0 + bj * 128;
                    const v4u g = *(const v4u*)(P + (size_t)row * NIN + C_GB + c);
                    const float* mp = MX + (size_t)row * DM + c; const f32x4 a0 = *(const f32x4*)mp, a1 = *(const f32x4*)(mp + 4);
                    const f32x4 v0 = acc[ai][bj][m][0], v1 = acc[ai][bj][m][1];
                    v4u w;
                    w.x = pk2(a0[0] + sigmoidf_(bf_lo(g.x)) * v0[0], a0[1] + sigmoidf_(bf_hi(g.x)) * v0[1]);
                    w.y = pk2(a0[2] + sigmoidf_(bf_lo(g.y)) * v0[2], a0[3] + sigmoidf_(bf_hi(g.y)) * v0[3]);
                    w.z = pk2(a1[0] + sigmoidf_(bf_lo(g.z)) * v1[0], a1[1] + sigmoidf_(bf_hi(g.z)) * v1[1]);
                    w.w = pk2(a1[2] + sigmoidf_(bf_lo(g.w)) * v1[2], a1[3] + sigmoidf_(bf_hi(g.w)) * v1[3]);
                    *(v4u*)(MB + (size_t)row * DM + c) = w; } }
    }
};
struct EpiRes {
    static constexpr bool PERM = true, AFTER_DRAIN = false;
    const float* b0; const float* b1; float* O;
    __device__ __forceinline__ void operator()(const pg8::f32x4 (&acc)[2][2][4][2], const pg8::Unit& u, int wr, int wc, int fr, int fq) const {
        const int row0 = u.pm * 256 + wr * 64 + fr, c0 = u.pn * 256 + wc * 32 + 8 * fq;
#pragma unroll
        for (int ai = 0; ai < 2; ++ai)
#pragma unroll
            for (int m = 0; m < 4; ++m) { const int row = row0 + ai * 128 + m * 16;
                const float* bp = (row < TP ? b0 + (size_t)row * DM : b1 + (size_t)(row - TP) * DM) + c0; float* op = O + (size_t)row * DM + c0;
#pragma unroll
                for (int bj = 0; bj < 2; ++bj) { const f32x4 x0 = *(const f32x4*)(bp + bj * 128), x1 = *(const f32x4*)(bp + bj * 128 + 4);
                    *(f32x4*)(op + bj * 128) = x0 + acc[ai][bj][m][0]; *(f32x4*)(op + bj * 128 + 4) = x1 + acc[ai][bj][m][1]; } }
    }
};
struct EpiUp {
    static constexpr bool PERM = true, AFTER_DRAIN = false;
    bf16* U;
    __device__ __forceinline__ void operator()(const pg8::f32x4 (&acc)[2][2][4][2], const pg8::Unit& u, int wr, int wc, int fr, int fq) const {
        const int row0 = u.pm * 256 + wr * 64 + fr, c0 = u.pn * 256 + wc * 32 + 8 * fq;
#pragma unroll
        for (int ai = 0; ai < 2; ++ai)
#pragma unroll
            for (int m = 0; m < 4; ++m) { bf16* rp = U + (size_t)(row0 + ai * 128 + m * 16) * DFF + c0;
#pragma unroll
                for (int bj = 0; bj < 2; ++bj) { f32x4 v0 = acc[ai][bj][m][0], v1 = acc[ai][bj][m][1];
#pragma unroll
                    for (int j = 0; j < 4; ++j) { const float a = fmaxf(v0[j], 0.f), b = fmaxf(v1[j], 0.f); v0[j] = a * a; v1[j] = b * b; }
                    v4u w; w.x = pk2(v0[0], v0[1]); w.y = pk2(v0[2], v0[3]); w.z = pk2(v1[0], v1[1]); w.w = pk2(v1[2], v1[3]);
                    *(v4u*)(rp + bj * 128) = w; } }
    }
};
#define XB_TMO      128
#define XB_XCNT(j)  (256  + 64 * (j))
#define XB_XSUB(j)  (1280 + 64 * (j))
#define XB_XGEN(j)  (2304 + 64 * (j))
#define XB_TOP      3328
#define XB_TOPGEN   3392
#define XCD_BAR_WORDS 3456
#define XB_SPIN_CAP (1u << 18)

__device__ __forceinline__ unsigned xb_ld(unsigned* p)              { return __hip_atomic_load(p, __ATOMIC_RELAXED, __HIP_MEMORY_SCOPE_AGENT); }
__device__ __forceinline__ unsigned xb_add(unsigned* p, unsigned v) { return __hip_atomic_fetch_add(p, v, __ATOMIC_RELAXED, __HIP_MEMORY_SCOPE_AGENT); }
__device__ __forceinline__ unsigned xb_xcc_id() { return (unsigned)__builtin_amdgcn_s_getreg((3 << 11) | 20) & 0xFu; }
#define XB_SPIN(cond, bar) do { unsigned _sp = 0; while (cond) { __builtin_amdgcn_s_sleep(1); \
    if ((++_sp & 255u) == 0u) { if (xb_ld(&(bar)[XB_TMO])) break; if (_sp > XB_SPIN_CAP) { atomicAdd(&(bar)[XB_TMO], 1u); break; } } } } while (0)

struct XcdBarrier {
    unsigned* bar; unsigned x;
    volatile LAS unsigned* st;
};

__device__ __forceinline__ XcdBarrier xcd_barrier_post(unsigned* bar, volatile LAS unsigned* st) {
    XcdBarrier b; b.bar = bar; b.x = xb_xcc_id(); b.st = st;
    if (threadIdx.x == 0) (void)xb_add(&bar[XB_XCNT(b.x)], 1u);
    return b;
}
__device__ __forceinline__ void xcd_barrier_complete(unsigned* bar, unsigned x, unsigned& nloc, unsigned& nx) {
    const unsigned G = gridDim.x * gridDim.y * gridDim.z;
    unsigned sum, cnt, mine, sp = 0u;
    for (;;) {
        sum = 0u; cnt = 0u; mine = 0u;
#pragma unroll
        for (unsigned j = 0; j < 16; ++j) { const unsigned c = xb_ld(&bar[XB_XCNT(j)]); sum += c; cnt += (c > 0u) ? 1u : 0u; mine = (j == x) ? c : mine; }
        if (sum == G) break;
        __builtin_amdgcn_s_sleep(1);
        if ((++sp & 255u) == 0u) { if (xb_ld(&bar[XB_TMO])) break; if (sp > XB_SPIN_CAP) { atomicAdd(&bar[XB_TMO], 1u); break; } }
    }
    nloc = mine > 0u ? mine : 1u; nx = cnt > 0u ? cnt : 1u;
}

__device__ __forceinline__ void xcd_barrier(const XcdBarrier& b) {
    asm volatile("s_waitcnt vmcnt(0)" ::: "memory");
    __syncthreads();
    if (threadIdx.x == 0) {
        unsigned* bar = b.bar;
        __builtin_amdgcn_s_waitcnt(0);
        unsigned nloc = b.st[0], nx = b.st[1];
        if (nloc == 0u) { xcd_barrier_complete(bar, b.x, nloc, nx); b.st[0] = nloc; b.st[1] = nx; }
        const unsigned old = xb_add(&bar[XB_XSUB(b.x)], 1u);
        const unsigned gen = old / nloc;
        if (old + 1u == (gen + 1u) * nloc) {
            __builtin_amdgcn_fence(__ATOMIC_RELEASE, "agent");
            asm volatile("s_waitcnt vmcnt(0)" ::: "memory");
            const unsigned og = xb_add(&bar[XB_TOP], 1u);
            const unsigned tg = og / nx;
            if (og + 1u == (tg + 1u) * nx) xb_add(&bar[XB_TOPGEN], 1u);
            else XB_SPIN(xb_ld(&bar[XB_TOPGEN]) == tg, bar);
            __builtin_amdgcn_fence(__ATOMIC_ACQUIRE, "agent");
            xb_add(&bar[XB_XGEN(b.x)], 1u);
            asm volatile("s_waitcnt vmcnt(0)" ::: "memory");
        } else {
            XB_SPIN(xb_ld(&bar[XB_XGEN(b.x)]) == gen, bar);
            __builtin_amdgcn_fence(__ATOMIC_ACQUIRE, "agent");
            asm volatile("s_waitcnt vmcnt(0)" ::: "memory");
        }
    }
    __syncthreads();
}

__device__ __forceinline__ int src_col_in(int nd) {
    if (nd < 4160) return nd;
    if (nd < 4224) return 14416 + (nd - 4160);
    if (nd < 4240) return 4160 + (nd - 4224);
    if (nd < 4352) return -1;
    if (nd < 8448) return 4176 + (nd - 4352);
    if (nd < 14592) return 8272 + (nd - 8448);
    if (nd < 16640) return 14480 + (nd - 14592);
    return 16528 + (nd - 16640);
}
template <bool MAP>
__device__ __forceinline__ void transpose_item(const float* W, int K, int Nsrc, bf16* WT, int nblk, int item, LAS float* scr, int lane) {
    const int kb = item / nblk, nb = item - kb * nblk, k0 = kb * 64, n0 = nb * 64;
    const int nd = n0 + 4 * (lane & 15);
    const int sc = MAP ? src_col_in(nd) : nd;
    f32x4 v[16];
#pragma unroll
    for (int i = 0; i < 16; ++i) { const int kk = (lane >> 4) + 4 * i;
        v[i] = (sc >= 0) ? *(const f32x4*)(W + (size_t)(k0 + kk) * Nsrc + sc) : (f32x4){0.f, 0.f, 0.f, 0.f}; }
#pragma unroll
    for (int i = 0; i < 16; ++i) { const int kk = (lane >> 4) + 4 * i; LAS float* d = scr + kk * 65 + 4 * (lane & 15);
        d[0] = v[i][0]; d[1] = v[i][1]; d[2] = v[i][2]; d[3] = v[i][3]; }
    LDS_WAIT();
    const int c = lane & 7;
#pragma unroll
    for (int j = 0; j < 8; ++j) { const int n = (lane >> 3) + 8 * j; const LAS float* s = scr + (8 * c) * 65 + n;
        v4u o; o.x = pk2(s[0 * 65], s[1 * 65]); o.y = pk2(s[2 * 65], s[3 * 65]); o.z = pk2(s[4 * 65], s[5 * 65]); o.w = pk2(s[6 * 65], s[7 * 65]);
        *(v4u*)(WT + (size_t)(n0 + n) * K + k0 + 8 * c) = o; }
    LDS_WAIT();
}
__device__ __forceinline__ void rms_row_to_bf16(const float* xrow, const float* g, bf16* orow, int lane) {
    f32x4 v[8]; float s = 0.f;
#pragma unroll
    for (int j = 0; j < 8; ++j) { v[j] = *(const f32x4*)(xrow + 4 * lane + 256 * j); s += (v[j][0] * v[j][0] + v[j][1] * v[j][1]) + (v[j][2] * v[j][2] + v[j][3] * v[j][3]); }
    const float r = rsqrtf(wave_sum(s) * (1.f / DM) + EPS);
#pragma unroll
    for (int j = 0; j < 8; ++j) { const f32x4 gg = *(const f32x4*)(g + 4 * lane + 256 * j);
        v2u o; o.x = pk2(v[j][0] * r * gg[0], v[j][1] * r * gg[1]); o.y = pk2(v[j][2] * r * gg[2], v[j][3] * r * gg[3]);
        *(v2u*)(orow + 4 * lane + 256 * j) = o; }
}
__device__ __forceinline__ void phase_prologue(const Params& p, LAS unsigned char* lds, int gw, int ngw, int wave, int lane) {
    LAS float* scr = (LAS float*)(lds + wave * 16640);
    unsigned char* ws = p.ws;
    constexpr int I_IN = (DM / 64) * (NIN / 64), I_PA = 32 * 32, I_PS = 64 * 32, I_OUT = 32 * 32, I_UP = 32 * 128, I_DN = 128 * 32;
    constexpr int NIT = I_IN + I_PA + I_PS + I_OUT + I_UP + I_DN;
    for (int it = gw; it < NIT; it += ngw) {
        int r = it;
        if (r < I_IN) { transpose_item<true>(p.in[9], DM, NIN_SRC, (bf16*)(ws + WS_WIN), NIN / 64, r, scr, lane); continue; } r -= I_IN;
        if (r < I_PA) { transpose_item<false>(p.in[20], DM, DM, (bf16*)(ws + WS_WPA), DM / 64, r, scr, lane); continue; } r -= I_PA;
        if (r < I_PS) { transpose_item<false>(p.in[21], DI, DM, (bf16*)(ws + WS_WPS), DM / 64, r, scr, lane); continue; } r -= I_PS;
        if (r < I_OUT) { transpose_item<false>(p.in[22], DM, DM, (bf16*)(ws + WS_WOUT), DM / 64, r, scr, lane); continue; } r -= I_OUT;
        if (r < I_UP) { transpose_item<false>(p.in[24], DM, DFF, (bf16*)(ws + WS_WUP), DFF / 64, r, scr, lane); continue; } r -= I_UP;
        transpose_item<false>(p.in[25], DFF, DM, (bf16*)(ws + WS_WDN), DM / 64, r, scr, lane);
    }
    for (int m = gw; m < MT; m += ngw) rms_row_to_bf16(xrow_ptr(p, m), p.in[8], (bf16*)(ws + WS_XN) + (size_t)m * DM, lane);
}

constexpr float LOG2_THETA = 13.287712379549449f;
__device__ __forceinline__ void p2_row(const Params& p, int r, int lane) {
    unsigned char* ws = p.ws;
    bf16* prow = (bf16*)(ws + WS_PROJ) + (size_t)r * NIN;
    const float* frow = (const float*)(ws + WS_PF) + (size_t)r * PF_LD;
    const int pos = r < TP ? r : PAST + ((r - TP) & 3);
    const float fpos = (float)pos;
    const int i0 = 2 * (lane & 31);
    const float a0 = fpos * exp2f(-(float)i0 * (LOG2_THETA / 64.f)), a1 = fpos * exp2f(-(float)(i0 + 1) * (LOG2_THETA / 64.f));
    const float c0 = cosf(a0), s0 = sinf(a0), c1 = cosf(a1), s1 = sinf(a1);
    {
        const float* g = p.in[10];
        const float g0 = g[i0], g1 = g[i0 + 1], g2 = g[64 + i0], g3 = g[64 + i0 + 1];
#pragma unroll
        for (int it = 0; it < 8; ++it) {
            bf16* hp = prow + C_Q + (2 * it + (lane >> 5)) * 128 + i0;
            const unsigned w1 = *(const unsigned*)hp, w2 = *(const unsigned*)(hp + 64);
            float x0 = bf_lo(w1), x1 = bf_hi(w1), y0 = bf_lo(w2), y1 = bf_hi(w2);
            float ss = (x0 * x0 + x1 * x1) + (y0 * y0 + y1 * y1);
#pragma unroll
            for (int o = 1; o < 32; o <<= 1) ss += __shfl_xor(ss, o);
            const float rr = rsqrtf(ss * (1.f / 128.f) + EPS);
            x0 *= rr * g0; x1 *= rr * g1; y0 *= rr * g2; y1 *= rr * g3;
            *(unsigned*)hp = pk2(x0 * c0 - y0 * s0, x1 * c1 - y1 * s1);
            *(unsigned*)(hp + 64) = pk2(y0 * c0 + x0 * s0, y1 * c1 + x1 * s1);
        }
    }
    float* outk = p.out + (r < TP ? O_KP + (size_t)r * 512 : O_KS + (size_t)(r - TP) * 512);
    float* outv = p.out + (r < TP ? O_VP + (size_t)r * 512 : O_VS + (size_t)(r - TP) * 512);
    {
        const float* g = p.in[11];
        const float g0 = g[i0], g1 = g[i0 + 1], g2 = g[64 + i0], g3 = g[64 + i0 + 1];
        bf16* kb = (bf16*)(ws + WS_KB) + (size_t)r * 512;
#pragma unroll
        for (int it = 0; it < 2; ++it) {
            const int off = (2 * it + (lane >> 5)) * 128 + i0;
            const f32x2 xa = *(const f32x2*)(frow + PF_K + off), xb = *(const f32x2*)(frow + PF_K + off + 64);
            float x0 = xa[0], x1 = xa[1], y0 = xb[0], y1 = xb[1];
            float ss = (x0 * x0 + x1 * x1) + (y0 * y0 + y1 * y1);
#pragma unroll
            for (int o = 1; o < 32; o <<= 1) ss += __shfl_xor(ss, o);
            const float rr = rsqrtf(ss * (1.f / 128.f) + EPS);
            x0 *= rr * g0; x1 *= rr * g1; y0 *= rr * g2; y1 *= rr * g3;
            const float o0 = x0 * c0 - y0 * s0, o1 = x1 * c1 - y1 * s1, o2 = y0 * c0 + x0 * s0, o3 = y1 * c1 + x1 * s1;
            *(f32x2*)(outk + off) = (f32x2){o0, o1}; *(f32x2*)(outk + off + 64) = (f32x2){o2, o3};
            *(unsigned*)(kb + off) = pk2(o0, o1); *(unsigned*)(kb + off + 64) = pk2(o2, o3);
        }
    }
    {
        bf16* vb = (bf16*)(ws + WS_VB) + (size_t)r * 512;
#pragma unroll
        for (int j = 0; j < 2; ++j) { const int off = 4 * lane + 256 * j; const f32x4 v = *(const f32x4*)(frow + PF_V + off);
            *(f32x4*)(outv + off) = v; v2u o; o.x = pk2(v[0], v[1]); o.y = pk2(v[2], v[3]); *(v2u*)(vb + off) = o; }
    }
    const int j0 = 2 * (lane & 15);
    const float b0 = fpos * exp2f(-(float)j0 * (LOG2_THETA / 32.f)), b1 = fpos * exp2f(-(float)(j0 + 1) * (LOG2_THETA / 32.f));
    const float d0 = cosf(b0), t0 = sinf(b0), d1 = cosf(b1), t1 = sinf(b1);
#pragma unroll
    for (int it = 0; it < 4; ++it) {
        bf16* hp = prow + C_IQ + (4 * it + (lane >> 4)) * 64 + j0;
        const unsigned w1 = *(const unsigned*)hp, w2 = *(const unsigned*)(hp + 32);
        const float x0 = bf_lo(w1), x1 = bf_hi(w1), y0 = bf_lo(w2), y1 = bf_hi(w2);
        *(unsigned*)hp = pk2(x0 * d0 - y0 * t0, x1 * d1 - y1 * t1);
        *(unsigned*)(hp + 32) = pk2(y0 * d0 + x0 * t0, y1 * d1 + x1 * t1);
    }
    {
        const f32x2 xa = *(const f32x2*)(frow + PF_IK + j0), xb = *(const f32x2*)(frow + PF_IK + 32 + j0);
        float s = (xa[0] + xa[1]) + (xb[0] + xb[1]);
#pragma unroll
        for (int o = 1; o < 16; o <<= 1) s += __shfl_xor(s, o);
        const float mean = s * (1.f / 64.f);
        const float e0 = xa[0] - mean, e1 = xa[1] - mean, e2 = xb[0] - mean, e3 = xb[1] - mean;
        float q = (e0 * e0 + e1 * e1) + (e2 * e2 + e3 * e3);
#pragma unroll
        for (int o = 1; o < 16; o <<= 1) q += __shfl_xor(q, o);
        const float rs = rsqrtf(q * (1.f / 64.f) + EPS);
        const float* g = p.in[12]; const float* b = p.in[13];
        const float x0 = e0 * rs * g[j0] + b[j0], x1 = e1 * rs * g[j0 + 1] + b[j0 + 1], y0 = e2 * rs * g[32 + j0] + b[32 + j0], y1 = e3 * rs * g[33 + j0] + b[33 + j0];
        const float o0 = x0 * d0 - y0 * t0, o1 = x1 * d1 - y1 * t1, o2 = y0 * d0 + x0 * t0, o3 = y1 * d1 + x1 * t1;
        if (lane < 16) {
            float* oi = p.out + (r < TP ? O_IKP + (size_t)r * 64 : O_IKS + (size_t)(r - TP) * 64);
            *(f32x2*)(oi + j0) = (f32x2){o0, o1}; *(f32x2*)(oi + 32 + j0) = (f32x2){o2, o3};
            bf16* ib = (bf16*)(ws + WS_IKB) + (size_t)r * 64;
            *(unsigned*)(ib + j0) = pk2(o0, o1); *(unsigned*)(ib + 32 + j0) = pk2(o2, o3);
        }
    }
    if (lane < 16) ((float*)(ws + WS_IWB))[(size_t)r * 16 + lane] = frow[PF_IW + lane] * (1.f / 32.f);
    {
        const float x = frow[PF_DT + lane] + p.in[16][lane];
        ((float*)(ws + WS_DTB))[(size_t)r * 64 + lane] = fmaxf(x, 0.f) + log1pf(expf(-fabsf(x)));
    }
}
__device__ __forceinline__ void conv_unit_prompt(const Params& p, int unit, int lane) {
    unsigned char* ws = p.ws;
    const int tb = unit / 12, slab = unit - tb * 12, t0 = tb * 8, ch0 = slab * 512 + 8 * lane;
    const bf16* xb = (const bf16*)(ws + WS_PROJ) + C_XBC + ch0;
    v4u xr[11];
#pragma unroll
    for (int j = 0; j < 11; ++j) { const int t = t0 - 3 + j; xr[j] = (v4u){0u, 0u, 0u, 0u}; if (t >= 0) xr[j] = *(const v4u*)(xb + (size_t)t * NIN); }
    float cw[4][8], cb[8];
#pragma unroll
    for (int i = 0; i < 4; ++i) { const f32x4 a = *(const f32x4*)(p.in[14] + (size_t)i * CONVD + ch0), b = *(const f32x4*)(p.in[14] + (size_t)i * CONVD + ch0 + 4);
        cw[i][0] = a[0]; cw[i][1] = a[1]; cw[i][2] = a[2]; cw[i][3] = a[3]; cw[i][4] = b[0]; cw[i][5] = b[1]; cw[i][6] = b[2]; cw[i][7] = b[3]; }
    { const f32x4 a = *(const f32x4*)(p.in[15] + ch0), b = *(const f32x4*)(p.in[15] + ch0 + 4);
      cb[0] = a[0]; cb[1] = a[1]; cb[2] = a[2]; cb[3] = a[3]; cb[4] = b[0]; cb[5] = b[1]; cb[6] = b[2]; cb[7] = b[3]; }
#define UNPK(dst, WW) do { dst[0] = bf_lo((WW)[0]); dst[1] = bf_hi((WW)[0]); dst[2] = bf_lo((WW)[1]); dst[3] = bf_hi((WW)[1]); dst[4] = bf_lo((WW)[2]); dst[5] = bf_hi((WW)[2]); dst[6] = bf_lo((WW)[3]); dst[7] = bf_hi((WW)[3]); } while (0)
    if (t0 == TP - 8) {
#pragma unroll
        for (int j = 0; j < 3; ++j) { float x[8]; UNPK(x, xr[8 + j]); float* o = p.out + O_CVP + (size_t)j * CONVD + ch0;
            *(f32x4*)o = (f32x4){x[0], x[1], x[2], x[3]}; *(f32x4*)(o + 4) = (f32x4){x[4], x[5], x[6], x[7]}; }
    }
    unsigned wt[8][4];
    v4u wr[8];
    float prev[8];
#pragma unroll
    for (int j = 0; j < 8; ++j) {
        float x0[8], x1[8], x2[8], x3[8], y[8];
        UNPK(x0, xr[j]); UNPK(x1, xr[j + 1]); UNPK(x2, xr[j + 2]); UNPK(x3, xr[j + 3]);
#pragma unroll
        for (int e = 0; e < 8; ++e) { const float a = cb[e] + (x0[e] * cw[0][e] + x1[e] * cw[1][e]) + (x2[e] * cw[2][e] + x3[e] * cw[3][e]); y[e] = siluf_(a); }
        wr[j].x = pk2(y[0], y[1]); wr[j].y = pk2(y[2], y[3]); wr[j].z = pk2(y[4], y[5]); wr[j].w = pk2(y[6], y[7]);
        if ((j & 1) == 0) {
#pragma unroll
            for (int e = 0; e < 8; ++e) prev[e] = y[e];
        } else {
#pragma unroll
            for (int e = 0; e < 8; ++e) wt[e][j >> 1] = pk2(prev[e], y[e]);
        }
    }
#undef UNPK
    const int c = t0 >> 7, sl = t0 & 127;
    if (ch0 < DI) {
        bf16* xt = (bf16*)(ws + WS_XT) + ((size_t)c * DI + ch0) * 128 + sl;
#pragma unroll
        for (int e = 0; e < 8; ++e) *(v4u*)(xt + (size_t)e * 128) = (v4u){wt[e][0], wt[e][1], wt[e][2], wt[e][3]};
    } else if (ch0 < DI + 1024) {
        const int nn = ch0 - DI;
        bf16* br = (bf16*)(ws + WS_BROW) + (size_t)t0 * 1024 + nn;
#pragma unroll
        for (int j = 0; j < 8; ++j) *(v4u*)(br + (size_t)j * 1024) = wr[j];
        bf16* bt = (bf16*)(ws + WS_BT) + ((size_t)c * 1024 + nn) * 128 + sl;
#pragma unroll
        for (int e = 0; e < 8; ++e) *(v4u*)(bt + (size_t)e * 128) = (v4u){wt[e][0], wt[e][1], wt[e][2], wt[e][3]};
    } else {
        const int nn = ch0 - DI - 1024;
        bf16* cr = (bf16*)(ws + WS_CROW) + (size_t)t0 * 1024 + nn;
#pragma unroll
        for (int j = 0; j < 8; ++j) *(v4u*)(cr + (size_t)j * 1024) = wr[j];
    }
}
__device__ __forceinline__ void conv_unit_sample(const Params& p, int unit, int lane) {
    unsigned char* ws = p.ws;
    const int b = unit / 12, slab = unit - b * 12, ch0 = slab * 512 + 8 * lane;
    v4u xr[7];
#pragma unroll
    for (int j = 0; j < 3; ++j) { const float* s = p.in[5] + ((size_t)b * 3 + j) * CONVD + ch0; const f32x4 a = *(const f32x4*)s, c = *(const f32x4*)(s + 4);
        xr[j].x = pk2(a[0], a[1]); xr[j].y = pk2(a[2], a[3]); xr[j].z = pk2(c[0], c[1]); xr[j].w = pk2(c[2], c[3]); }
    const bf16* xb = (const bf16*)(ws + WS_PROJ) + (size_t)(TP + 4 * b) * NIN + C_XBC + ch0;
#pragma unroll
    for (int j = 0; j < 4; ++j) xr[3 + j] = *(const v4u*)(xb + (size_t)j * NIN);
    float cw[4][8], cb[8];
#pragma unroll
    for (int i = 0; i < 4; ++i) { const f32x4 a = *(const f32x4*)(p.in[14] + (size_t)i * CONVD + ch0), c = *(const f32x4*)(p.in[14] + (size_t)i * CONVD + ch0 + 4);
        cw[i][0] = a[0]; cw[i][1] = a[1]; cw[i][2] = a[2]; cw[i][3] = a[3]; cw[i][4] = c[0]; cw[i][5] = c[1]; cw[i][6] = c[2]; cw[i][7] = c[3]; }
    { const f32x4 a = *(const f32x4*)(p.in[15] + ch0), c = *(const f32x4*)(p.in[15] + ch0 + 4);
      cb[0] = a[0]; cb[1] = a[1]; cb[2] = a[2]; cb[3] = a[3]; cb[4] = c[0]; cb[5] = c[1]; cb[6] = c[2]; cb[7] = c[3]; }
#define UNPK(dst, WW) do { dst[0] = bf_lo((WW)[0]); dst[1] = bf_hi((WW)[0]); dst[2] = bf_lo((WW)[1]); dst[3] = bf_hi((WW)[1]); dst[4] = bf_lo((WW)[2]); dst[5] = bf_hi((WW)[2]); dst[6] = bf_lo((WW)[3]); dst[7] = bf_hi((WW)[3]); } while (0)
#pragma unroll
    for (int j = 0; j < 3; ++j) { float x[8]; UNPK(x, xr[4 + j]); float* o = p.out + O_CVS + ((size_t)b * 3 + j) * CONVD + ch0;
        *(f32x4*)o = (f32x4){x[0], x[1], x[2], x[3]}; *(f32x4*)(o + 4) = (f32x4){x[4], x[5], x[6], x[7]}; }
    bf16* xo = (bf16*)(ws + WS_XBS) + (size_t)(4 * b) * CONVD + ch0;
#pragma unroll
    for (int j = 0; j < 4; ++j) { float x0[8], x1[8], x2[8], x3[8], y[8];
        UNPK(x0, xr[j]); UNPK(x1, xr[j + 1]); UNPK(x2, xr[j + 2]); UNPK(x3, xr[j + 3]);
#pragma unroll
        for (int e = 0; e < 8; ++e) { const float a = cb[e] + (x0[e] * cw[0][e] + x1[e] * cw[1][e]) + (x2[e] * cw[2][e] + x3[e] * cw[3][e]); y[e] = siluf_(a); }
        v4u w; w.x = pk2(y[0], y[1]); w.y = pk2(y[2], y[3]); w.z = pk2(y[4], y[5]); w.w = pk2(y[6], y[7]); *(v4u*)(xo + (size_t)j * CONVD) = w; }
#undef UNPK
}

__device__ __forceinline__ unsigned fkey(float f) { const unsigned u = __float_as_uint(f); return (u & 0x80000000u) ? ~u : (u | 0x80000000u); }
#define MFMA32(a, b, c) __builtin_amdgcn_mfma_f32_32x32x16_bf16((a), (b), (c), 0, 0, 0)
#define MFMA16(a, b, c) __builtin_amdgcn_mfma_f32_16x16x32_bf16((a), (b), (c), 0, 0, 0)
__device__ __forceinline__ void score_unit_prompt(const Params& p, int unit, int wave, int lane) {
    unsigned char* ws = p.ws;
    int j = 0; while (8 * (j + 1) * (j + 2) <= unit) ++j;
    const int v = unit - 8 * j * (j + 1), qb = 16 * j + v / (j + 1), kc = v % (j + 1);
    const int tw = 32 * qb + 4 * wave, r = lane & 31, hh = lane >> 5;
    const bf16* proj = (const bf16*)(ws + WS_PROJ);
    const float* iw = (const float*)(ws + WS_IWB);
    bf16x8 af[2][4]; f32x4 wv[2][4];
#pragma unroll
    for (int rt = 0; rt < 2; ++rt) {
        const int tok = tw + 2 * rt + ((r >> 2) & 1), head = (r & 3) + 4 * (r >> 3);
#pragma unroll
        for (int kk = 0; kk < 4; ++kk) af[rt][kk] = *(const bf16x8*)(proj + (size_t)tok * NIN + C_IQ + head * 64 + 16 * kk + 8 * hh);
#pragma unroll
        for (int q = 0; q < 4; ++q) wv[rt][q] = *(const f32x4*)(iw + (size_t)(tw + 2 * rt + hh) * 16 + 4 * q);
    }
    const bf16* ikb = (const bf16*)(ws + WS_IKB);
    unsigned* sc = (unsigned*)(ws + WS_SC);
#pragma unroll 2
    for (int kt = 0; kt < 16; ++kt) {
        const int s0 = 512 * kc + 32 * kt;
        if (s0 > tw + 3) break;
        bf16x8 bfr[4];
#pragma unroll
        for (int kk = 0; kk < 4; ++kk) bfr[kk] = *(const bf16x8*)(ikb + (size_t)(s0 + r) * 64 + 16 * kk + 8 * hh);
#pragma unroll
        for (int rt = 0; rt < 2; ++rt) {
            f32x16 acc;
#pragma unroll
            for (int i = 0; i < 16; ++i) acc[i] = 0.f;
#pragma unroll
            for (int kk = 0; kk < 4; ++kk) acc = MFMA32(af[rt][kk], bfr[kk], acc);
            float s = 0.f;
#pragma unroll
            for (int i = 0; i < 16; ++i) s += wv[rt][i >> 2][i & 3] * fmaxf(acc[i], 0.f);
            sc[(size_t)(tw + 2 * rt + hh) * TP + s0 + r] = fkey(s);
        }
    }
}
__device__ __forceinline__ void score_job_sample(const Params& p, int job, int lane) {
    unsigned char* ws = p.ws;
    const int b = job / 9, ktg = job - b * 9, r = lane & 31, hh = lane >> 5;
    const bf16* proj = (const bf16*)(ws + WS_PROJ);
    const float* iw = (const float*)(ws + WS_IWB);
    bf16x8 af[2][4]; f32x4 wv[2][4];
#pragma unroll
    for (int rt = 0; rt < 2; ++rt) {
        const int tok = TP + 4 * b + 2 * rt + ((r >> 2) & 1), head = (r & 3) + 4 * (r >> 3);
#pragma unroll
        for (int kk = 0; kk < 4; ++kk) af[rt][kk] = *(const bf16x8*)(proj + (size_t)tok * NIN + C_IQ + head * 64 + 16 * kk + 8 * hh);
#pragma unroll
        for (int q = 0; q < 4; ++q) wv[rt][q] = *(const f32x4*)(iw + (size_t)(TP + 4 * b + 2 * rt + hh) * 16 + 4 * q);
    }
    const bf16* ikb = (const bf16*)(ws + WS_IKB);
    const int* pt = (const int*)p.in[7] + b * 16;
    unsigned* sc = (unsigned*)(ws + WS_SCS);
    for (int kt = 8 * ktg; kt < 8 * ktg + 8 && kt < 65; ++kt) {
        const int key = 32 * kt + r;
        bf16x8 bfr[4];
        if (key < PAST) {
            const float* src = p.in[4] + ((size_t)pt[key >> 7] * 128 + (key & 127)) * 64 + 8 * hh;
#pragma unroll
            for (int kk = 0; kk < 4; ++kk) { const f32x4 a = *(const f32x4*)(src + 16 * kk), c = *(const f32x4*)(src + 16 * kk + 4);
                v4u w; w.x = pk2(a[0], a[1]); w.y = pk2(a[2], a[3]); w.z = pk2(c[0], c[1]); w.w = pk2(c[2], c[3]); bfr[kk] = __builtin_bit_cast(bf16x8, w); }
        } else if (key < NKS) {
#pragma unroll
            for (int kk = 0; kk < 4; ++kk) bfr[kk] = *(const bf16x8*)(ikb + (size_t)(TP + 4 * b + key - PAST) * 64 + 16 * kk + 8 * hh);
        } else {
#pragma unroll
            for (int kk = 0; kk < 4; ++kk) bfr[kk] = (bf16x8){0, 0, 0, 0, 0, 0, 0, 0};
        }
#pragma unroll
        for (int rt = 0; rt < 2; ++rt) {
            f32x16 acc;
#pragma unroll
            for (int i = 0; i < 16; ++i) acc[i] = 0.f;
#pragma unroll
            for (int kk = 0; kk < 4; ++kk) acc = MFMA32(af[rt][kk], bfr[kk], acc);
            float s = 0.f;
#pragma unroll
            for (int i = 0; i < 16; ++i) s += wv[rt][i >> 2][i & 3] * fmaxf(acc[i], 0.f);
            if (key < NKS) sc[(size_t)(4 * b + 2 * rt + hh) * SCS_LD + key] = fkey(s);
        }
    }
}

template <bool SAMPLE>
__device__ __forceinline__ int sel_resolve(const int* pt, int b, int j) { if (!SAMPLE) return j; return j < PAST ? pt[j >> 7] * 128 + (j & 127) : (0x40000000 | (4 * b + j - PAST)); }
template <bool SAMPLE>
__device__ __forceinline__ void select_row(const Params& p, int row, LAS unsigned* hist, int lane) {
    unsigned char* ws = p.ws;
    const int n = SAMPLE ? (PAST + 1 + ((row - TP) & 3)) : (row + 1);
    const int b = SAMPLE ? ((row - TP) >> 2) : 0;
    const unsigned* keys = SAMPLE ? (const unsigned*)(ws + WS_SCS) + (size_t)(row - TP) * SCS_LD : (const unsigned*)(ws + WS_SC) + (size_t)row * TP;
    const int* pt = (const int*)p.in[7] + b * 16;
    int* sel = (int*)(ws + WS_SEL) + (size_t)row * 256;
    int* cnt = (int*)(ws + WS_CNT) + row;
    if (n <= 256) {
        for (int i = 0; i < 4; ++i) { const int j = i * 64 + lane; sel[j] = sel_resolve<SAMPLE>(pt, b, j < n ? j : 0); }
        if (lane == 0) *cnt = n;
        return;
    }
    const int nch = (n + 63) >> 6;
    unsigned prefix = 0u, pmask = 0u; int need = 256;
    for (int level = 0; level < 4; ++level) {
        const int shift = level == 0 ? 22 : (level == 1 ? 12 : (level == 2 ? 2 : 0));
        const unsigned dm = level < 3 ? 1023u : 3u;
#pragma unroll
        for (int q = 0; q < 16; ++q) hist[q * 64 + lane] = 0u;
        LDS_WAIT();
#pragma unroll 4
        for (int i = 0; i < nch; ++i) { const int j = i * 64 + lane;
            if (j < n) { const unsigned k = keys[j];
                if ((k & pmask) == prefix) __hip_atomic_fetch_add(hist + ((k >> shift) & dm), 1u, __ATOMIC_RELAXED, __HIP_MEMORY_SCOPE_WORKGROUP); } }
        LDS_WAIT();
        unsigned h[16]; unsigned s = 0u;
#pragma unroll
        for (int q = 0; q < 16; ++q) { h[q] = hist[16 * lane + q]; s += h[q]; }
        unsigned S = s;
#pragma unroll
        for (int o = 1; o < 64; o <<= 1) { const unsigned t = __shfl_down(S, o); if (lane + o < 64) S += t; }
        const unsigned long long bal = __ballot(S >= (unsigned)need);
        const int L = 63 - __builtin_clzll(bal);
        unsigned cabove = S - s;
        int dsel = 0; unsigned csel = 0u; bool found = false;
#pragma unroll
        for (int q = 15; q >= 0; --q) { if (!found) { if (cabove + h[q] >= (unsigned)need) { dsel = 16 * lane + q; csel = cabove; found = true; } else cabove += h[q]; } }
        const int d = __shfl(dsel, L); const unsigned ca = __shfl(csel, L);
        need -= (int)ca; prefix |= ((unsigned)d) << shift; pmask |= dm << shift;
        LDS_WAIT();
    }
    const unsigned T = prefix;
    int pos = 0, eqtaken = 0;
    const unsigned long long lt = (1ull << lane) - 1ull;
#pragma unroll 2
    for (int i = 0; i < nch; ++i) {
        const int j = i * 64 + lane; const bool valid = j < n;
        const unsigned k = valid ? keys[j] : 0u;
        const bool gt = valid && k > T, eq = valid && k == T;
        const unsigned long long me = __ballot(eq);
        const bool esel = eq && (eqtaken + __popcll(me & lt) < need);
        const bool s_ = gt || esel;
        const unsigned long long ms = __ballot(s_);
        if (s_) sel[pos + __popcll(ms & lt)] = sel_resolve<SAMPLE>(pt, b, j);
        pos += __popcll(ms); eqtaken += __popcll(me);
    }
    if (lane == 0) *cnt = 256;
}

__device__ __forceinline__ unsigned vt_off(unsigned row, unsigned ch) { return 256u * row + 16u * (ch ^ (((row & 3) << 2) | ((row >> 2) & 3))); }
template <bool SAMPLE>
__device__ __forceinline__ void attn_job(const Params& p, int row, int g, LAS unsigned char* vt, int lane) {
    unsigned char* ws = p.ws;
    const int* sel = (const int*)(ws + WS_SEL) + (size_t)row * 256;
    const int cnt = ((const int*)(ws + WS_CNT))[row];
    const int hd = lane & 15, kq = lane >> 4;
    const bf16* kbp = (const bf16*)(ws + WS_KB); const bf16* vbp = (const bf16*)(ws + WS_VB);
    const float* ck = p.in[2]; const float* cv = p.in[3]; const float* nk = p.out + O_KS; const float* nv = p.out + O_VS;
    bf16x8 qf[4];
#pragma unroll
    for (int kk = 0; kk < 4; ++kk) {
        qf[kk] = (bf16x8){0, 0, 0, 0, 0, 0, 0, 0};
        if (hd < 4) qf[kk] = *(const bf16x8*)((const bf16*)(ws + WS_PROJ) + (size_t)row * NIN + C_Q + (4 * g + hd) * 128 + 32 * kk + 8 * kq);
    }
    const float sl2 = 0.08838834764831845f * 1.4426950408889634f;
    float m_run = -1e30f, l_run = 0.f;
    f32x4 o[8];
#pragma unroll
    for (int c = 0; c < 8; ++c) o[c] = (f32x4){0.f, 0.f, 0.f, 0.f};
    for (int ch = 0; ch < 8; ++ch) {
        if (32 * ch >= cnt) break;
        const int ea = sel[32 * ch + hd], eb = sel[32 * ch + 16 + hd];
        bf16x8 ka[4], kb[4];
        if (!SAMPLE) {
            const bf16* pa = kbp + (size_t)ea * 512 + g * 128 + 8 * kq; const bf16* pb = kbp + (size_t)eb * 512 + g * 128 + 8 * kq;
#pragma unroll
            for (int kk = 0; kk < 4; ++kk) { ka[kk] = *(const bf16x8*)(pa + 32 * kk); kb[kk] = *(const bf16x8*)(pb + 32 * kk); }
        } else {
            const float* pa = ((ea & 0x40000000) ? nk + (size_t)(ea & 0xffff) * 512 : ck + (size_t)ea * 512) + g * 128 + 8 * kq;
            const float* pb = ((eb & 0x40000000) ? nk + (size_t)(eb & 0xffff) * 512 : ck + (size_t)eb * 512) + g * 128 + 8 * kq;
#pragma unroll
            for (int kk = 0; kk < 4; ++kk) {
                const f32x4 a0 = *(const f32x4*)(pa + 32 * kk), a1 = *(const f32x4*)(pa + 32 * kk + 4), b0 = *(const f32x4*)(pb + 32 * kk), b1 = *(const f32x4*)(pb + 32 * kk + 4);
                v4u wa, wb; wa.x = pk2(a0[0], a0[1]); wa.y = pk2(a0[2], a0[3]); wa.z = pk2(a1[0], a1[1]); wa.w = pk2(a1[2], a1[3]);
                wb.x = pk2(b0[0], b0[1]); wb.y = pk2(b0[2], b0[3]); wb.z = pk2(b1[0], b1[1]); wb.w = pk2(b1[2], b1[3]);
                ka[kk] = __builtin_bit_cast(bf16x8, wa); kb[kk] = __builtin_bit_cast(bf16x8, wb); }
        }
        {
            const int c16 = lane & 15, rs = lane >> 4;
#pragma unroll
            for (int i = 0; i < 8; ++i) { const int slot = rs + 4 * i; const int e = sel[32 * ch + slot];
                v4u w;
                if (!SAMPLE) w = *(const v4u*)(vbp + (size_t)e * 512 + g * 128 + 8 * c16);
                else { const float* pv = ((e & 0x40000000) ? nv + (size_t)(e & 0xffff) * 512 : cv + (size_t)e * 512) + g * 128 + 8 * c16;
                    const f32x4 a0 = *(const f32x4*)pv, a1 = *(const f32x4*)(pv + 4); w.x = pk2(a0[0], a0[1]); w.y = pk2(a0[2], a0[3]); w.z = pk2(a1[0], a1[1]); w.w = pk2(a1[2], a1[3]); }
                *(LAS v4u*)(vt + vt_off(slot, c16)) = w; }
        }
        f32x4 sa = (f32x4){0.f, 0.f, 0.f, 0.f}, sb = (f32x4){0.f, 0.f, 0.f, 0.f};
#pragma unroll
        for (int kk = 0; kk < 4; ++kk) { sa = MFMA16(ka[kk], qf[kk], sa); sb = MFMA16(kb[kk], qf[kk], sb); }
        float mx = -1e30f;
#pragma unroll
        for (int i = 0; i < 4; ++i) {
            sa[i] = (32 * ch + 4 * kq + i < cnt) ? sa[i] * sl2 : -1e30f; sb[i] = (32 * ch + 16 + 4 * kq + i < cnt) ? sb[i] * sl2 : -1e30f;
            mx = fmaxf(mx, fmaxf(sa[i], sb[i])); }
        mx = fmaxf(mx, __shfl_xor(mx, 16)); mx = fmaxf(mx, __shfl_xor(mx, 32));
        const float m_new = fmaxf(m_run, mx), alpha = exp2f(m_run - m_new);
        float ps = 0.f; float pa_[4], pb_[4];
#pragma unroll
        for (int i = 0; i < 4; ++i) { pa_[i] = exp2f(sa[i] - m_new); pb_[i] = exp2f(sb[i] - m_new); ps += pa_[i] + pb_[i]; }
        ps += __shfl_xor(ps, 16); ps += __shfl_xor(ps, 32);
        l_run = l_run * alpha + ps; m_run = m_new;
        v4u pw; pw.x = pk2(pa_[0], pa_[1]); pw.y = pk2(pa_[2], pa_[3]); pw.z = pk2(pb_[0], pb_[1]); pw.w = pk2(pb_[2], pb_[3]);
        const bf16x8 pf = __builtin_bit_cast(bf16x8, pw);
        const float al0 = __shfl(alpha, 0), al1 = __shfl(alpha, 1), al2 = __shfl(alpha, 2), al3 = __shfl(alpha, 3);
#pragma unroll
        for (int c = 0; c < 8; ++c) { o[c][0] *= al0; o[c][1] *= al1; o[c][2] *= al2; o[c][3] *= al3; }
        LDS_WAIT();
        const unsigned q4 = (unsigned)(hd >> 2), p4 = (unsigned)(lane & 3);
#pragma unroll
        for (int c = 0; c < 8; ++c) {
            const unsigned r0 = 4u * kq + q4, r1 = 16u + 4u * kq + q4, chk = 2u * c + (p4 >> 1);
            const v4i16_t lo = __builtin_amdgcn_ds_read_tr16_b64_v4i16((LAS v4i16_t*)(vt + vt_off(r0, chk) + 8u * (p4 & 1u)));
            const v4i16_t hi = __builtin_amdgcn_ds_read_tr16_b64_v4i16((LAS v4i16_t*)(vt + vt_off(r1, chk) + 8u * (p4 & 1u)));
            const bf16x8 vf = (bf16x8){lo[0], lo[1], lo[2], lo[3], hi[0], hi[1], hi[2], hi[3]};
            o[c] = MFMA16(pf, vf, o[c]);
        }
        LDS_WAIT();
    }
    const float l0 = __shfl(l_run, 0), l1 = __shfl(l_run, 1), l2 = __shfl(l_run, 2), l3 = __shfl(l_run, 3);
    if (lane < 16) {
        bf16* ao = (bf16*)(ws + WS_AO) + (size_t)row * DM + (4 * g) * 128 + lane;
        const float i0 = 1.f / l0, i1 = 1.f / l1, i2 = 1.f / l2, i3 = 1.f / l3;
#pragma unroll
        for (int c = 0; c < 8; ++c) {
            ao[0 * 128 + 16 * c] = (bf16)(pk2(o[c][0] * i0, 0.f) & 0xffffu); ao[1 * 128 + 16 * c] = (bf16)(pk2(o[c][1] * i1, 0.f) & 0xffffu);
            ao[2 * 128 + 16 * c] = (bf16)(pk2(o[c][2] * i2, 0.f) & 0xffffu); ao[3 * 128 + 16 * c] = (bf16)(pk2(o[c][3] * i3, 0.f) & 0xffffu); }
    }
}

__device__ __forceinline__ float wave_scan_incl(float v, int lane) {
#pragma unroll
    for (int o = 1; o < 64; o <<= 1) { const float t = __shfl_up(v, o); if (lane >= o) v += t; }
    return v;
}
__device__ __forceinline__ bf16x8 scale_frag(bf16x8 x, const LAS float* f) {
    const v4u w = __builtin_bit_cast(v4u, x); const f32x4 f0 = *(const LAS f32x4*)f, f1 = *(const LAS f32x4*)(f + 4);
    v4u o; o.x = pk2(bf_lo(w.x) * f0[0], bf_hi(w.x) * f0[1]); o.y = pk2(bf_lo(w.y) * f0[2], bf_hi(w.y) * f0[3]);
    o.z = pk2(bf_lo(w.z) * f1[0], bf_hi(w.z) * f1[1]); o.w = pk2(bf_lo(w.w) * f1[2], bf_hi(w.w) * f1[3]);
    return __builtin_bit_cast(bf16x8, o);
}
__device__ __forceinline__ void ssd_chunk_state(const Params& p, int c, int h, LAS float* fa, int lane) {
    unsigned char* ws = p.ws;
    const int g = h >> 3, t0 = 128 * c, r = lane & 31, hh = lane >> 5;
    const float* dtb = (const float*)(ws + WS_DTB);
    const float a = -expf(p.in[17][h]);
    const float d0 = dtb[(size_t)(t0 + lane) * 64 + h], d1 = dtb[(size_t)(t0 + 64 + lane) * 64 + h];
    const float c0 = wave_scan_incl(d0 * a, lane), tot0 = __shfl(c0, 63);
    const float c1 = wave_scan_incl(d1 * a, lane) + tot0, last = __shfl(c1, 63);
    fa[lane] = d0 * expf(last - c0); fa[64 + lane] = d1 * expf(last - c1);
    if (lane == 0) ((float*)(ws + WS_CSL))[c * 64 + h] = last;
    LDS_WAIT();
    f32x16 acc[2][4];
#pragma unroll
    for (int a_ = 0; a_ < 2; ++a_)
#pragma unroll
        for (int b_ = 0; b_ < 4; ++b_)
#pragma unroll
            for (int i = 0; i < 16; ++i) acc[a_][b_][i] = 0.f;
    const bf16* xt = (const bf16*)(ws + WS_XT) + ((size_t)(c * 64 + h) * 64 + r) * 128 + 8 * hh;
    const bf16* bt = (const bf16*)(ws + WS_BT) + ((size_t)(c * 8 + g) * 128 + r) * 128 + 8 * hh;
#pragma unroll 2
    for (int ks = 0; ks < 8; ++ks) {
        bf16x8 af[2], bf_[4];
#pragma unroll
        for (int pt = 0; pt < 2; ++pt) af[pt] = scale_frag(*(const bf16x8*)(xt + (size_t)pt * 32 * 128 + 16 * ks), fa + 16 * ks + 8 * hh);
#pragma unroll
        for (int ct = 0; ct < 4; ++ct) bf_[ct] = *(const bf16x8*)(bt + (size_t)ct * 32 * 128 + 16 * ks);
#pragma unroll
        for (int pt = 0; pt < 2; ++pt)
#pragma unroll
            for (int ct = 0; ct < 4; ++ct) acc[pt][ct] = MFMA32(af[pt], bf_[ct], acc[pt][ct]);
    }
    float* cs = (float*)(ws + WS_CS) + (size_t)(c * 64 + h) * 64 * 128;
#pragma unroll
    for (int pt = 0; pt < 2; ++pt)
#pragma unroll
        for (int ct = 0; ct < 4; ++ct)
#pragma unroll
            for (int i = 0; i < 16; ++i) { const int pp = 32 * pt + (i & 3) + 8 * (i >> 2) + 4 * hh; cs[(size_t)pp * 128 + 32 * ct + r] = acc[pt][ct][i]; }
    LDS_WAIT();
}
__device__ __forceinline__ void ssd_state_scan(const Params& p, int gtid, int gthreads) {
    unsigned char* ws = p.ws;
    const float* csl = (const float*)(ws + WS_CSL);
    for (int e = gtid; e < 64 * 64 * 32; e += gthreads) {
        const int h = e >> 11;
        const float* cs = (const float*)(ws + WS_CS) + (size_t)e * 4;
        bf16* st = (bf16*)(ws + WS_STIN) + (size_t)e * 4;
        f32x4 cur = (f32x4){0.f, 0.f, 0.f, 0.f};
#pragma unroll 8
        for (int c = 0; c < 64; ++c) {
            const f32x4 t = *(const f32x4*)(cs + (size_t)c * 524288);
            v2u o; o.x = pk2(cur[0], cur[1]); o.y = pk2(cur[2], cur[3]); *(v2u*)(st + (size_t)c * 524288) = o;
            const float dec = expf(csl[c * 64 + h]);
            cur = cur * dec + t;
        }
        *(f32x4*)(p.out + O_SSP + (size_t)e * 4) = cur;
    }
}
__device__ __forceinline__ void ssd_output_unit(const Params& p, int c, int g, LAS float* wl  , LAS float* ex  , int wave, int lane) {
    unsigned char* ws = p.ws;
    const int h = 8 * g + wave, t0 = 128 * c, r = lane & 31, hh = lane >> 5;
    const float* dtb = (const float*)(ws + WS_DTB);
    const float a = -expf(p.in[17][h]);
    {
        const float d0 = dtb[(size_t)(t0 + lane) * 64 + h], d1 = dtb[(size_t)(t0 + 64 + lane) * 64 + h];
        const float c0 = wave_scan_incl(d0 * a, lane), tot0 = __shfl(c0, 63);
        const float c1 = wave_scan_incl(d1 * a, lane) + tot0;
        wl[lane] = c0; wl[64 + lane] = c1; wl[128 + lane] = d0; wl[192 + lane] = d1;
        LDS_WAIT();
    }
    const bf16* crow = (const bf16*)(ws + WS_CROW) + (size_t)t0 * 1024 + g * 128 + 8 * hh;
    const bf16* brow = (const bf16*)(ws + WS_BROW) + (size_t)t0 * 1024 + g * 128 + 8 * hh;
    const bf16* stin = (const bf16*)(ws + WS_STIN) + ((size_t)(c * 64 + h) * 64 + r) * 128 + 8 * hh;
    const bf16* xt = (const bf16*)(ws + WS_XT) + ((size_t)(c * 64 + h) * 64 + r) * 128;
    const bf16* zp = (const bf16*)(ws + WS_PROJ) + (size_t)t0 * NIN + C_Z + h * 64 + r;
    const float dsk = p.in[18][h];
    bf16* so = (bf16*)(ws + WS_SSMO) + (size_t)t0 * DI + h * 64;
#pragma unroll 1
    for (int li_ = 0; li_ < 4; ++li_) {
        const int li = li_;
        f32x16 Y[1][2];
#define Y_(a) Y[0]
        bf16x8 cf[8];
#pragma unroll
        for (int kk = 0; kk < 8; ++kk) cf[kk] = *(const bf16x8*)(crow + (size_t)(32 * li + r) * 1024 + 16 * kk);
#pragma unroll
        for (int pt = 0; pt < 2; ++pt)
#pragma unroll
            for (int i = 0; i < 16; ++i) Y[0][pt][i] = 0.f;
#pragma unroll
        for (int kk = 0; kk < 8; ++kk)
#pragma unroll
            for (int pt = 0; pt < 2; ++pt) { const bf16x8 sf = *(const bf16x8*)(stin + (size_t)pt * 32 * 128 + 16 * kk); Y[0][pt] = MFMA32(cf[kk], sf, Y[0][pt]); if (pt == 1 && (kk & 1)) asm volatile("" ::: "memory"); }
#pragma unroll
        for (int i = 0; i < 16; ++i) { const float e = expf(wl[32 * li + (i & 3) + 8 * (i >> 2) + 4 * hh]); Y[0][0][i] *= e; Y[0][1][i] *= e; }
        const float csl_ = wl[32 * li + r];
#pragma unroll 1
        for (int si = 0; si <= li; ++si) {
            {
                f32x16 X;
#pragma unroll
                for (int i = 0; i < 16; ++i) X[i] = 0.f;
#pragma unroll
                for (int kk = 0; kk < 8; ++kk) { const bf16x8 bf_ = *(const bf16x8*)(brow + (size_t)(32 * si + r) * 1024 + 16 * kk); X = MFMA32(bf_, cf[kk], X); if ((kk & 3) == 3) asm volatile("" ::: "memory"); }
#pragma unroll
                for (int i = 0; i < 16; ++i) { const int sl = 32 * si + (i & 3) + 8 * (i >> 2) + 4 * hh, ll = 32 * li + r;
                    X[i] = (sl <= ll) ? X[i] * expf(csl_ - wl[sl]) * wl[128 + sl] : 0.f; }
#pragma unroll
                for (int st = 0; st < 2; ++st) {
                    v4u aw; aw.x = pk2(X[8 * st + 0], X[8 * st + 1]); aw.y = pk2(X[8 * st + 2], X[8 * st + 3]); aw.z = pk2(X[8 * st + 4], X[8 * st + 5]); aw.w = pk2(X[8 * st + 6], X[8 * st + 7]);
                    const bf16x8 af = __builtin_bit_cast(bf16x8, aw);
#pragma unroll
                    for (int pt = 0; pt < 2; ++pt) {
                        const bf16* xp = xt + (size_t)pt * 32 * 128 + 32 * si + 16 * st + 4 * hh;
                        const v2u lo = *(const v2u*)xp, hi = *(const v2u*)(xp + 8);
                        const v4u bw = (v4u){lo.x, lo.y, hi.x, hi.y};
                        Y[0][pt] = MFMA32(af, __builtin_bit_cast(bf16x8, bw), Y[0][pt]);
                    }
                }
            }
        }
        float sq[16];
#pragma unroll
        for (int i = 0; i < 16; ++i) sq[i] = 0.f;
#pragma unroll
        for (int pt = 0; pt < 2; ++pt) {
#pragma unroll
            for (int q = 0; q < 4; ++q) {
                const v2u xw = *(const v2u*)(xt + (size_t)pt * 32 * 128 + 32 * li + 8 * q + 4 * hh);
                const float xv[4] = {bf_lo(xw.x), bf_hi(xw.x), bf_lo(xw.y), bf_hi(xw.y)};
#pragma unroll
                for (int e = 0; e < 4; ++e) { const int i = 4 * q + e; const int l = 32 * li + 8 * q + 4 * hh + e;
                    const float z = bf1(zp[(size_t)l * NIN + 32 * pt]);
                    const float y = (Y[0][pt][i] + dsk * xv[e]) * siluf_(z);
                    sq[i] += y * y; so[(size_t)l * DI + 32 * pt + r] = (bf16)(pk2(y, 0.f) & 0xffffu); }
            }
        }
#pragma unroll
        for (int i = 0; i < 16; ++i) { float s = sq[i];
#pragma unroll
            for (int o = 1; o < 32; o <<= 1) s += __shfl_xor(s, o);
            if (r == 0) ex[(32 * li + (i & 3) + 8 * (i >> 2) + 4 * hh) * 8 + wave] = s; }
    }
#undef Y_
    LDS_WAIT(); VM_WAIT();
    __syncthreads();
    {
        const int chn = lane & 7, rsb = lane >> 3;
        const f32x4 g0 = *(const f32x4*)(p.in[19] + h * 64 + 8 * chn), g1 = *(const f32x4*)(p.in[19] + h * 64 + 8 * chn + 4);
#pragma unroll 4
        for (int k = 0; k < 16; ++k) { const int l = rsb + 8 * k;
            const LAS f32x4* e4 = (const LAS f32x4*)(ex + l * 8); const f32x4 ea = e4[0], eb = e4[1];
            const float tot = ((ea[0] + ea[1]) + (ea[2] + ea[3])) + ((eb[0] + eb[1]) + (eb[2] + eb[3]));
            const float rs = rsqrtf(tot * (1.f / 512.f) + EPS);
            bf16* q = so + (size_t)l * DI + 8 * chn; const v4u w = *(const v4u*)q;
            v4u o; o.x = pk2(bf_lo(w.x) * rs * g0[0], bf_hi(w.x) * rs * g0[1]); o.y = pk2(bf_lo(w.y) * rs * g0[2], bf_hi(w.y) * rs * g0[3]);
            o.z = pk2(bf_lo(w.z) * rs * g1[0], bf_hi(w.z) * rs * g1[1]); o.w = pk2(bf_lo(w.w) * rs * g1[2], bf_hi(w.w) * rs * g1[3]);
            *(v4u*)q = o; }
    }
    __syncthreads();
}
__device__ __forceinline__ void ssd_sample_unit(const Params& p, int b, int g, LAS float* ex  , int wave, int lane) {
    unsigned char* ws = p.ws;
    const int h = 8 * g + wave, r0 = TP + 4 * b, pq = lane >> 4, nq = lane & 15;
    const float* dtb = (const float*)(ws + WS_DTB);
    const float a = -expf(p.in[17][h]);
    float dt[4], cs[4];
#pragma unroll
    for (int s = 0; s < 4; ++s) { dt[s] = dtb[(size_t)(r0 + s) * 64 + h]; cs[s] = dt[s] * a + (s ? cs[s - 1] : 0.f); }
    const bf16* xbs = (const bf16*)(ws + WS_XBS) + (size_t)(4 * b) * CONVD;
    float Bn[4][8], Cn[4][8];
#pragma unroll
    for (int s = 0; s < 4; ++s) {
        const bf16* bp = xbs + (size_t)s * CONVD + DI + g * 128 + 8 * nq; const bf16* cp = bp + 1024;
        const v4u b0 = *(const v4u*)bp, c0 = *(const v4u*)cp;
        const unsigned bw[4] = {b0.x, b0.y, b0.z, b0.w}, cw[4] = {c0.x, c0.y, c0.z, c0.w};
#pragma unroll
        for (int j = 0; j < 4; ++j) { Bn[s][2 * j] = bf_lo(bw[j]); Bn[s][2 * j + 1] = bf_hi(bw[j]); Cn[s][2 * j] = bf_lo(cw[j]); Cn[s][2 * j + 1] = bf_hi(cw[j]); }
    }
    float cbm[4][4];
#pragma unroll
    for (int l = 0; l < 4; ++l)
#pragma unroll
        for (int s = 0; s < 4; ++s) { float v = 0.f;
            if (s <= l) {
#pragma unroll
                for (int j = 0; j < 8; ++j) v += Cn[l][j] * Bn[s][j];
                v += __shfl_xor(v, 1); v += __shfl_xor(v, 2); v += __shfl_xor(v, 4); v += __shfl_xor(v, 8);
                v *= expf(cs[l] - cs[s]) * dt[s]; }
            cbm[l][s] = v; }
    float ecs[4], fdec[4];
#pragma unroll
    for (int s = 0; s < 4; ++s) { ecs[s] = expf(cs[s]); fdec[s] = dt[s] * expf(cs[3] - cs[s]); }
    const float e3 = ecs[3], dsk = p.in[18][h];
    const float* sin_ = p.in[6] + ((size_t)(b * 64 + h) * 64) * 128 + 8 * nq;
    float* sout = p.out + O_SSS + ((size_t)(b * 64 + h) * 64) * 128 + 8 * nq;
    const bf16* zp = (const bf16*)(ws + WS_PROJ) + (size_t)r0 * NIN + C_Z + h * 64;
    float sq[4] = {0.f, 0.f, 0.f, 0.f};
    bf16* so = (bf16*)(ws + WS_SSMO) + (size_t)r0 * DI + h * 64;
    f32x4 S[2];
#pragma unroll
    for (int q = 0; q < 2; ++q) S[q] = *(const f32x4*)(sin_ + (size_t)pq * 128 + 4 * q);
#pragma unroll 1
    for (int i = 0; i < 16; ++i) {
        const int pp = pq + 4 * i;
        const int ppn = (i < 15) ? pp + 4 : pp;
        f32x4 Sn[2];
#pragma unroll
        for (int q = 0; q < 2; ++q) Sn[q] = *(const f32x4*)(sin_ + (size_t)ppn * 128 + 4 * q);
        float xs[4], xd[4];
#pragma unroll
        for (int s = 0; s < 4; ++s) { xs[s] = bf1(xbs[(size_t)s * CONVD + h * 64 + pp]); xd[s] = xs[s] * fdec[s]; }
        float yo[4] = {0.f, 0.f, 0.f, 0.f};
#pragma unroll
        for (int q = 0; q < 2; ++q)
#pragma unroll
            for (int e = 0; e < 4; ++e) { const float sv = S[q][e]; const int j = 4 * q + e;
#pragma unroll
                for (int l = 0; l < 4; ++l) yo[l] += Cn[l][j] * sv;
                S[q][e] = e3 * sv + ((Bn[0][j] * xd[0] + Bn[1][j] * xd[1]) + (Bn[2][j] * xd[2] + Bn[3][j] * xd[3])); }
#pragma unroll
        for (int q = 0; q < 2; ++q) *(f32x4*)(sout + (size_t)pp * 128 + 4 * q) = S[q];
#pragma unroll
        for (int l = 0; l < 4; ++l) { float v = yo[l]; v += __shfl_xor(v, 1); v += __shfl_xor(v, 2); v += __shfl_xor(v, 4); v += __shfl_xor(v, 8);
            float yd = 0.f;
#pragma unroll
            for (int s = 0; s < 4; ++s) if (s <= l) yd += cbm[l][s] * xs[s];
            const float z = bf1(zp[(size_t)l * NIN + pp]);
            const float y = (v * ecs[l] + yd + dsk * xs[l]) * siluf_(z);
            if (nq == 0) { sq[l] += y * y; so[(size_t)l * DI + pp] = (bf16)(pk2(y, 0.f) & 0xffffu); } }
#pragma unroll
        for (int q = 0; q < 2; ++q) S[q] = Sn[q];
    }
#pragma unroll
    for (int l = 0; l < 4; ++l) { const float s = wave_sum(sq[l]); if (lane == 0) ex[l * 8 + wave] = s; }
    LDS_WAIT(); VM_WAIT();
    __syncthreads();
    if (lane < 32) {
        const int l = lane >> 3, chn = lane & 7;
        float tot = 0.f;
#pragma unroll
        for (int w = 0; w < 8; ++w) tot += ex[l * 8 + w];
        const float rs = rsqrtf(tot * (1.f / 512.f) + EPS);
        const f32x4 g0 = *(const f32x4*)(p.in[19] + h * 64 + 8 * chn), g1 = *(const f32x4*)(p.in[19] + h * 64 + 8 * chn + 4);
        bf16* q = so + (size_t)l * DI + 8 * chn; const v4u w = *(const v4u*)q;
        v4u o; o.x = pk2(bf_lo(w.x) * rs * g0[0], bf_hi(w.x) * rs * g0[1]); o.y = pk2(bf_lo(w.y) * rs * g0[2], bf_hi(w.y) * rs * g0[3]);
        o.z = pk2(bf_lo(w.z) * rs * g1[0], bf_hi(w.z) * rs * g1[1]); o.w = pk2(bf_lo(w.w) * rs * g1[2], bf_hi(w.w) * rs * g1[3]);
        *(v4u*)q = o;
    }
    __syncthreads();
}

#ifndef N_PHASES
#define N_PHASES 12
#endif
#ifndef ONE_LAUNCH
#define ONE_LAUNCH 1
#endif
__global__ void __launch_bounds__(NTHR, 2) fwd_kernel(Params p) {
    extern __shared__ __attribute__((aligned(16))) unsigned char lds_raw[];
    LAS unsigned char* lds = (LAS unsigned char*)lds_raw;
    const int wave = __builtin_amdgcn_readfirstlane((int)threadIdx.x >> 6);
#define LANE_ID() ({ int l_; asm volatile("v_mbcnt_lo_u32_b32 %0, -1, 0\n\tv_mbcnt_hi_u32_b32 %0, -1, %0" : "=v"(l_)); l_; })
    const int G = gridDim.x, blk = blockIdx.x;
    const int gw = blk * NWAVES + wave, ngw = G * NWAVES;
    unsigned char* ws = p.ws;
    volatile LAS unsigned* MISC = (volatile LAS unsigned*)(lds + MISC_OFF);
    { const int tid0 = wave * 64 + LANE_ID(); for (int u = tid0; u < (LDS_BYTES - CTL_OFF) / 4; u += NTHR) ((LAS unsigned*)(lds + CTL_OFF))[u] = 0u; }
    __syncthreads();
    XcdBarrier bar; bar.bar = (unsigned*)(ws + WS_CTL) + CW_BAR; bar.x = 0; bar.st = nullptr;
#if ONE_LAUNCH
    bar = xcd_barrier_post((unsigned*)(ws + WS_CTL) + CW_BAR, MISC + 8);
#endif
    const int lo = p.ph_lo, hi = p.ph_hi;
#ifndef PH_MASK
#define PH_MASK 0xFFF
#endif
#define IN(k) (((PH_MASK >> (k)) & 1) && lo <= (k) && (k) < hi)
#define SEAM(k) do { if (IN(k) && IN((k) + 1)) xcd_barrier(bar); } while (0)

    if (IN(0)) { const int lane = LANE_ID(); phase_prologue(p, lds, gw, ngw, wave, lane); }
    SEAM(0);
    if (IN(1)) {
        pg8::Gemm g{(const bf16*)(ws + WS_XN), (const bf16*)(ws + WS_WIN), MT, NIN, DM}; pg8::StaticOrder S; S.init(MT, NIN, G, blk);
        EpiIn E{(bf16*)(ws + WS_PROJ), (float*)(ws + WS_PF)};
        pg8::gemm_phase<EpiIn, pg8::StaticOrder, true, true>(lds, g, S, E);
    }
    SEAM(1);
    if (IN(2)) {
        const int lane = LANE_ID();
        for (int r = gw; r < MT; r += ngw) p2_row(p, r, lane);
        for (int u = gw; u < (TP / 8) * 12; u += ngw) conv_unit_prompt(p, u, lane);
        for (int u = gw; u < NB * 12; u += ngw) conv_unit_sample(p, u, lane);
    }
    SEAM(2);
    if (IN(3)) {
        const int lane = LANE_ID();
#ifndef P3S
#define P3S 15
#endif
        if (P3S & 1) for (int u = blk; u < 2176; u += G) score_unit_prompt(p, 2175 - u, wave, lane);
        if (P3S & 2) for (int j = gw; j < NB * 9; j += ngw) score_job_sample(p, j, lane);
        if (P3S & 4) for (int j = gw; j < 64 * 64; j += ngw) ssd_chunk_state(p, j >> 6, j & 63, (LAS float*)(lds + wave * 1024), lane);
        __syncthreads();
        if (P3S & 8) for (int u = blk; u < NB * 8; u += G) ssd_sample_unit(p, u >> 3, u & 7, (LAS float*)(lds + 16384), wave, lane);
    }
    SEAM(3);
    if (IN(4)) {
        const int lane = LANE_ID(); const int tid = wave * 64 + lane;
        LAS unsigned* hist = (LAS unsigned*)(lds + wave * 4096);
        for (int j = gw; j < TP; j += ngw) select_row<false>(p, TP - 1 - j, hist, lane);
        for (int j = gw; j < TS; j += ngw) select_row<true>(p, TP + j, hist, lane);
        ssd_state_scan(p, blk * NTHR + tid, G * NTHR);
    }
    SEAM(4);
    if (IN(5)) {
        const int lane = LANE_ID();
#ifndef P5S
#define P5S 7
#endif
        if (P5S & 1) for (int u = blk; u < 64 * 8; u += G) ssd_output_unit(p, u >> 3, u & 7, (LAS float*)(lds + wave * 1024), (LAS float*)(lds + 8192), wave, lane);
        __syncthreads();
        LAS unsigned char* vt = lds + wave * 8192;
        if (P5S & 2) for (int j = gw; j < TS * 4; j += ngw) attn_job<true>(p, TP + (j >> 2), j & 3, vt, lane);
        if (P5S & 4) for (int j = gw; j < TP * 4; j += ngw) attn_job<false>(p, TP - 1 - (j >> 2), j & 3, vt, lane);
    }
    SEAM(5);
    if (IN(6)) {
        pg8::Gemm g{(const bf16*)(ws + WS_AO), (const bf16*)(ws + WS_WPA), MT, DM, DM}; pg8::StaticOrder S; S.init(MT, DM, G, blk);
        EpiPA E{(const bf16*)(ws + WS_PROJ), (float*)(ws + WS_MIX32)};
        pg8::gemm_phase<EpiPA, pg8::StaticOrder, true, true>(lds, g, S, E);
    }
    if (IN(6) && IN(7)) { VM_WAIT(); __syncthreads(); }
    if (IN(7)) {
        pg8::Gemm g{(const bf16*)(ws + WS_SSMO), (const bf16*)(ws + WS_WPS), MT, DM, DI}; pg8::StaticOrder S; S.init(MT, DM, G, blk);
        EpiPS E{(const bf16*)(ws + WS_PROJ), (const float*)(ws + WS_MIX32), (bf16*)(ws + WS_MIXB)};
        pg8::gemm_phase<EpiPS, pg8::StaticOrder, true, true>(lds, g, S, E);
    }
    SEAM(7);
    if (IN(8)) {
        pg8::Gemm g{(const bf16*)(ws + WS_MIXB), (const bf16*)(ws + WS_WOUT), MT, DM, DM}; pg8::StaticOrder S; S.init(MT, DM, G, blk);
        EpiRes E{p.in[0], p.in[1], (float*)(ws + WS_H)};
        pg8::gemm_phase<EpiRes, pg8::StaticOrder, true, true>(lds, g, S, E);
    }
    SEAM(8);
    if (IN(9)) { const int lane = LANE_ID(); for (int m = gw; m < MT; m += ngw) rms_row_to_bf16((const float*)(ws + WS_H) + (size_t)m * DM, p.in[23], (bf16*)(ws + WS_HN) + (size_t)m * DM, lane); }
    SEAM(9);
    if (IN(10)) {
        pg8::Gemm g{(const bf16*)(ws + WS_HN), (const bf16*)(ws + WS_WUP), MT, DFF, DM}; pg8::StaticOrder S; S.init(MT, DFF, G, blk);
        EpiUp E{(bf16*)(ws + WS_U)};
        pg8::gemm_phase<EpiUp, pg8::StaticOrder, true, true>(lds, g, S, E);
    }
    SEAM(10);
    if (IN(11)) {
        pg8::Gemm g{(const bf16*)(ws + WS_U), (const bf16*)(ws + WS_WDN), MT, DM, DFF}; pg8::StaticOrder S; S.init(MT, DM, G, blk);
        const float* hb = (const float*)(ws + WS_H);
        EpiRes E{hb, hb + (size_t)TP * DM, p.out + O_Y};
        pg8::gemm_phase<EpiRes, pg8::StaticOrder, true, true>(lds, g, S, E);
    }
#undef IN
#undef SEAM
}

extern "C" void kernel_launch(void* const* d_in, const int* in_sizes, int n_in, void* d_out, int out_size, void* d_ws, size_t ws_size, hipStream_t stream) {
    static int grid = 0;
    if (grid == 0) {
        if (n_in != 26 || (size_t)out_size != O_END || ws_size < WS_END) { fprintf(stderr, "kernel_launch: unexpected shapes (n_in %d out %d ws %zu)\n", n_in, out_size, ws_size); grid = -1; return; }
        int dev = 0, cus = 0, per_cu = 0;
        if (hipGetDevice(&dev) != hipSuccess || hipDeviceGetAttribute(&cus, hipDeviceAttributeMultiprocessorCount, dev) != hipSuccess) { grid = -1; return; }
        if (hipFuncSetAttribute((const void*)fwd_kernel, hipFuncAttributeMaxDynamicSharedMemorySize, LDS_BYTES) != hipSuccess) { fprintf(stderr, "kernel_launch: hipFuncSetAttribute failed\n"); grid = -1; return; }
        if (hipOccupancyMaxActiveBlocksPerMultiprocessor(&per_cu, (const void*)fwd_kernel, NTHR, LDS_BYTES) != hipSuccess || per_cu < 1) fprintf(stderr, "kernel_launch: occupancy query reports %d\n", per_cu);
        (void)hipGetLastError();
        grid = cus;
    }
    if (grid < 0) return;
    (void)hipMemsetAsync((char*)d_ws + WS_CTL, 0, CTL_ZERO_BYTES, stream);
    Params a{};
    for (int i = 0; i < 26; ++i) a.in[i] = (const float*)d_in[i];
    a.out = (float*)d_out; a.ws = (unsigned char*)d_ws;
#if ONE_LAUNCH
    a.ph_lo = 0; a.ph_hi = N_PHASES;
    hipLaunchKernelGGL(fwd_kernel, dim3(grid), dim3(NTHR), LDS_BYTES, stream, a);
#else
    for (int ph = 0; ph < N_PHASES; ++ph) { a.ph_lo = ph; a.ph_hi = ph + 1; hipLaunchKernelGGL(fwd_kernel, dim3(grid), dim3(NTHR), LDS_BYTES, stream, a); }
#endif
}
```

```cpp
#include <hip/hip_runtime.h>
#include <cstdio>
#include <cstdint>
#define ONE_LAUNCH 1
namespace pg8 {
#define PG8_LAS __attribute__((address_space(3)))
typedef unsigned short bf16_t;
typedef short bf16x8 __attribute__((ext_vector_type(8)));
typedef float f32x4 __attribute__((ext_vector_type(4)));
typedef unsigned u32x4 __attribute__((ext_vector_type(4)));
constexpr int BM = 256, BK = 64, HALF = 128, HTB = HALF * BK * 2  , STAGE_BYTES = 8 * HTB, NXCD = 8, WGM = 8;

__host__ __device__ __forceinline__ int lds_byte(int r, int c) { const int st = (r >> 4) * 2 + (c >> 5), rr = r & 15, cc = c & 31, ob = rr * 64 + cc * 2; return st * 1024 + (ob ^ (((ob >> 9) & 1) << 5)); }
__host__ __device__ __forceinline__ void stage_rc(int b, int& R, int& C) { const int st = b / 1024, sb = b % 1024, swz = sb ^ (((sb >> 9) & 1) << 5); R = (st >> 1) * 16 + swz / 64; C = (st & 1) * 32 + (swz % 64) / 2; }
__host__ __device__ __forceinline__ int perm32(int rho) { const int n = rho >> 4, i = rho & 15; return 8 * (i >> 2) + 4 * n + (i & 3); }

struct Unit { int pm, pn; };
struct Gemm { const bf16_t* A; const bf16_t* Bt; int M, N, K; };

struct StaticOrder {
    int nM, nN, nwg, G, c;
    __host__ __device__ void init(int M, int N, int G_, int c_) { nM = M / BM; nN = N / BM; nwg = nM * nN; G = G_; c = c_; }
    __host__ __device__ bool next(int i, Unit& u) const {
        const long L = (long)i * G + c; if (L >= nwg) return false;
        int wgid = (int)L; { const int q = nwg / NXCD, r = nwg % NXCD, xcd = wgid % NXCD, off = wgid / NXCD; wgid = (xcd < r ? xcd * (q + 1) : r * (q + 1) + (xcd - r) * q) + off; }
        const int nig = WGM * nN, gid = wgid / nig, fm = gid * WGM, gsz = (nM - fm) < WGM ? (nM - fm) : WGM;
        u.pm = fm + ((wgid % nig) % gsz); u.pn = (wgid % nig) / gsz; return true;
    }
    __device__ __forceinline__ void a_ready(const Unit&) const {}
    __device__ __forceinline__ void done(const Unit&) const {}
};
__device__ __forceinline__ unsigned cvt_pk_bf16(float lo, float hi) { unsigned r; asm volatile("v_cvt_pk_bf16_f32 %0, %1, %2" : "=v"(r) : "v"(lo), "v"(hi)); return r; }
typedef float f32x2 __attribute__((ext_vector_type(2)));
template <class Epi, class Sched, bool ALIGN_EPI = false, bool SP2 = false>
__device__ __forceinline__ void gemm_phase(PG8_LAS unsigned char* lds, const Gemm g, const Sched& S, const Epi& E) {
    const int tid = threadIdx.x, wid = __builtin_amdgcn_readfirstlane(tid >> 6), lane = tid & 63, wr = wid >> 2, wc = wid & 3, fr = lane & 15, fq = lane >> 4;
    const int K = g.K, nt = K / BK;
    unsigned voffA[2], voffB[2];
#pragma unroll
    for (int i = 0; i < 2; ++i) { int R, C; stage_rc(tid * 16 + i * 8192, R, C); const int Rb = Epi::PERM ? ((R & ~31) + perm32(R & 31)) : R;
        voffA[i] = (unsigned)(R * K + C) * 2u; voffB[i] = (unsigned)(Rb * K + C) * 2u; }
    const size_t kstep = (size_t)(BK * 2);
    const size_t hstep = (size_t)HALF * K * 2;
    const size_t tstep = 2 * hstep;
    const unsigned ldsw = (unsigned)wid * 1024u;
    const int aoff = lds_byte(wr * 64 + fr, fq * 8), boff = lds_byte(wc * 32 + fr, fq * 8);
#define PG8_SA(b, h) (((b) * 2 + (h)) * HTB)
#define PG8_SB(b, h) ((4 + (b) * 2 + (h)) * HTB)
#define PG8_STAGE(bufoff, gbase, voff) do { _Pragma("unroll") for (int _i = 0; _i < 2; ++_i) \
        __builtin_amdgcn_global_load_lds((const unsigned*)((const char*)(gbase) + (voff)[_i]), (PG8_LAS unsigned*)(lds + (bufoff) + ldsw + _i * 8192), 16, 0, 0); } while (0)
#define PG8_LDA(dst, b, h) do { _Pragma("unroll") for (int m = 0; m < 4; ++m) _Pragma("unroll") for (int k = 0; k < 2; ++k) dst[m][k] = *(const PG8_LAS bf16x8*)(lds + PG8_SA(b, h) + aoff + m * 2048 + k * 1024); } while (0)
#define PG8_LDB(dst, b, h) do { _Pragma("unroll") for (int n = 0; n < 2; ++n) _Pragma("unroll") for (int k = 0; k < 2; ++k) dst[n][k] = *(const PG8_LAS bf16x8*)(lds + PG8_SB(b, h) + boff + n * 2048 + k * 1024); } while (0)
#define PG8_MMA(ai, bj, At, Bt) do { __builtin_amdgcn_s_setprio(1); _Pragma("unroll") for (int m = 0; m < 4; ++m) _Pragma("unroll") for (int n = 0; n < 2; ++n) _Pragma("unroll") for (int k = 0; k < 2; ++k) \
        acc[ai][bj][m][n] = __builtin_amdgcn_mfma_f32_16x16x32_bf16(Bt[n][k], At[m][k], acc[ai][bj][m][n], 0, 0, 0); __builtin_amdgcn_s_setprio(0); } while (0)
#define PG8_WAIT_V(n) asm volatile("s_waitcnt vmcnt(" #n ")" ::: "memory")
#define PG8_WAIT_L(n) asm volatile("s_waitcnt lgkmcnt(" #n ")" ::: "memory")
#define PG8_BAR __builtin_amdgcn_s_barrier()
#define PG8_SCHED __builtin_amdgcn_sched_barrier(0)
    Unit cur, nxt; int ui = 0;
    if (!S.next(0, cur)) return;
    f32x4 acc[2][2][4][2];
#pragma unroll
    for (int a = 0; a < 2; ++a)
#pragma unroll
        for (int b = 0; b < 2; ++b)
#pragma unroll
            for (int m = 0; m < 4; ++m)
#pragma unroll
                for (int n = 0; n < 2; ++n) acc[a][b][m][n] = (f32x4){0.f, 0.f, 0.f, 0.f};
    bf16x8 At[4][2], B0[2][2], B1[2][2];
    const char* cA = (const char*)g.A + (size_t)cur.pm * tstep; const char* cB = (const char*)g.Bt + (size_t)cur.pn * tstep;
    S.a_ready(cur);
    if constexpr (SP2) {
        PG8_STAGE(PG8_SB(0, 0), cB, voffB); PG8_STAGE(PG8_SB(0, 1), cB + hstep, voffB); PG8_STAGE(PG8_SA(0, 0), cA, voffA); PG8_STAGE(PG8_SA(0, 1), cA + hstep, voffA);
        if (wr == 1) PG8_BAR;
        PG8_WAIT_V(2); PG8_BAR;
        PG8_STAGE(PG8_SB(1, 0), cB + kstep, voffB); PG8_STAGE(PG8_SA(1, 0), cA + kstep, voffA); PG8_STAGE(PG8_SB(1, 1), cB + hstep + kstep, voffB);
        PG8_WAIT_V(6); PG8_BAR;
    } else {
        PG8_STAGE(PG8_SB(0, 0), cB, voffB); PG8_STAGE(PG8_SA(0, 0), cA, voffA); PG8_STAGE(PG8_SB(0, 1), cB + hstep, voffB); PG8_STAGE(PG8_SA(0, 1), cA + hstep, voffA);
        if (wr == 1) PG8_BAR;
        PG8_WAIT_V(4); PG8_BAR;
        PG8_STAGE(PG8_SB(1, 0), cB + kstep, voffB); PG8_STAGE(PG8_SA(1, 0), cA + kstep, voffA); PG8_STAGE(PG8_SB(1, 1), cB + hstep + kstep, voffB);
        PG8_WAIT_V(6); PG8_BAR;
    }
    for (;;) {
        const bool has_next = S.next(ui + 1, nxt);
        const char* nA = has_next ? (const char*)g.A + (size_t)nxt.pm * tstep : cA; const char* nB = has_next ? (const char*)g.Bt + (size_t)nxt.pn * tstep : cB;
        for (int t = 0; t < nt; t += 2) {
            const bool last = (t == nt - 2);
            const char* a1 = cA + (size_t)(t + 1) * kstep;
            const char* a2 = last ? nA : cA + (size_t)(t + 2) * kstep; const char* b2 = last ? nB : cB + (size_t)(t + 2) * kstep;
            const char* a3 = a2 + kstep; const char* b3 = b2 + kstep;
            if (last && has_next) S.a_ready(nxt);
            if constexpr (SP2) {
            PG8_LDB(B0, 0, 0); PG8_LDB(B1, 0, 1); PG8_SCHED; PG8_LDA(At, 0, 0); PG8_STAGE(PG8_SA(1, 1), a1 + hstep, voffA);
            PG8_WAIT_V(8); PG8_WAIT_L(0); PG8_BAR; PG8_MMA(0, 0, At, B0); PG8_MMA(0, 1, At, B1); PG8_BAR; PG8_SCHED;
            PG8_LDA(At, 0, 1); PG8_STAGE(PG8_SB(0, 0), b2, voffB); PG8_STAGE(PG8_SB(0, 1), b2 + hstep, voffB); PG8_STAGE(PG8_SA(0, 0), a2, voffA);
            PG8_WAIT_V(8); PG8_WAIT_L(0); PG8_BAR; PG8_MMA(1, 0, At, B0); PG8_MMA(1, 1, At, B1); PG8_BAR; PG8_SCHED;
            PG8_LDB(B0, 1, 0); PG8_LDB(B1, 1, 1); PG8_SCHED; PG8_LDA(At, 1, 0); PG8_STAGE(PG8_SA(0, 1), a2 + hstep, voffA);
            PG8_WAIT_V(8); PG8_WAIT_L(0); PG8_BAR; PG8_MMA(0, 0, At, B0); PG8_MMA(0, 1, At, B1); PG8_BAR; PG8_SCHED;
            PG8_LDA(At, 1, 1); PG8_STAGE(PG8_SB(1, 0), b3, voffB); PG8_STAGE(PG8_SB(1, 1), b3 + hstep, voffB); PG8_STAGE(PG8_SA(1, 0), a3, voffA);
            PG8_WAIT_V(8); PG8_WAIT_L(0); PG8_BAR; PG8_MMA(1, 0, At, B0); PG8_MMA(1, 1, At, B1); PG8_BAR; PG8_SCHED;
            } else {
            PG8_LDB(B0, 0, 0); PG8_SCHED; PG8_LDA(At, 0, 0); PG8_STAGE(PG8_SA(1, 1), a1 + hstep, voffA);
            PG8_WAIT_L(8); PG8_BAR; PG8_WAIT_L(0); PG8_MMA(0, 0, At, B0); PG8_BAR; PG8_SCHED;
            PG8_LDB(B1, 0, 1); PG8_STAGE(PG8_SB(0, 0), b2, voffB);
            PG8_BAR; PG8_WAIT_L(0); PG8_MMA(0, 1, At, B1); PG8_BAR;
            PG8_LDA(At, 0, 1); PG8_STAGE(PG8_SA(0, 0), a2, voffA);
            PG8_BAR; PG8_WAIT_L(0); PG8_MMA(1, 0, At, B0); PG8_BAR; PG8_SCHED;
            PG8_STAGE(PG8_SB(0, 1), b2 + hstep, voffB);
            PG8_WAIT_V(6); PG8_BAR; PG8_MMA(1, 1, At, B1); PG8_BAR;
            PG8_LDB(B0, 1, 0); PG8_SCHED; PG8_LDA(At, 1, 0); PG8_STAGE(PG8_SA(0, 1), a2 + hstep, voffA);
            PG8_WAIT_L(8); PG8_BAR; PG8_WAIT_L(0); PG8_MMA(0, 0, At, B0); PG8_BAR; PG8_SCHED;
            PG8_LDB(B1, 1, 1); PG8_STAGE(PG8_SB(1, 0), b3, voffB);
            PG8_BAR; PG8_WAIT_L(0); PG8_MMA(0, 1, At, B1); PG8_BAR;
            PG8_LDA(At, 1, 1); PG8_STAGE(PG8_SA(1, 0), a3, voffA);
            PG8_BAR; PG8_WAIT_L(0); PG8_MMA(1, 0, At, B0); PG8_BAR; PG8_SCHED;
            PG8_STAGE(PG8_SB(1, 1), b3 + hstep, voffB);
            PG8_WAIT_V(6); PG8_BAR; PG8_MMA(1, 1, At, B1); PG8_BAR;
            }
        }
        if constexpr (ALIGN_EPI) { if (wr == 0) PG8_BAR; }
        if constexpr (!Epi::AFTER_DRAIN) { E(acc, cur, wr, wc, fr, fq); S.done(cur); }
        if (!has_next) break;
#pragma unroll
        for (int a = 0; a < 2; ++a)
#pragma unroll
            for (int b = 0; b < 2; ++b)
#pragma unroll
                for (int m = 0; m < 4; ++m)
#pragma unroll
                    for (int n = 0; n < 2; ++n) acc[a][b][m][n] = (f32x4){0.f, 0.f, 0.f, 0.f};
        cur = nxt; cA = nA; cB = nB; ++ui;
        if constexpr (ALIGN_EPI) { if (wr == 1) PG8_BAR; }
    }
    PG8_WAIT_V(0);
    if constexpr (!ALIGN_EPI) { if (wr == 0) PG8_BAR; }
    PG8_BAR;
    if constexpr (Epi::AFTER_DRAIN) { E.fused(acc, cur, wr, wc, fr, fq, lds, wid, lane); S.done(cur); }
#undef PG8_SA
#undef PG8_SB
#undef PG8_STAGE
#undef PG8_LDA
#undef PG8_LDB
#undef PG8_MMA
#undef PG8_WAIT_V
#undef PG8_WAIT_L
#undef PG8_BAR
#undef PG8_SCHED
}
}

#define GAS __attribute__((address_space(1)))
#define LAS __attribute__((address_space(3)))
typedef unsigned short bf16;
typedef unsigned v4u __attribute__((ext_vector_type(4)));
typedef unsigned v2u __attribute__((ext_vector_type(2)));
typedef float f32x4 __attribute__((ext_vector_type(4)));
typedef float f32x2 __attribute__((ext_vector_type(2)));
typedef float f32x16 __attribute__((ext_vector_type(16)));
typedef short bf16x8 __attribute__((ext_vector_type(8)));
typedef short v4i16_t __attribute__((ext_vector_type(4)));

constexpr int NWAVES = 8, NTHR = 512;
constexpr int DM = 2048, TP = 8192, TS = 512, MT = TP + TS, NB = 128, DSEQ = 4, PAST = 2048;
constexpr int NIN_SRC = 18576, NIN = 18688;
constexpr int C_Q = 0, C_K = 2048, C_V = 2560, C_IQ = 3072, C_IK = 4096, C_DT = 4160, C_IW = 4224, C_Z = 4352, C_XBC = 8448, C_GA = 14592, C_GB = 16640;
constexpr int PF_LD = 1280, PF_K = 0, PF_V = 512, PF_IK = 1024, PF_DT = 1088, PF_IW = 1152;
constexpr int DI = 4096, CONVD = 6144, DFF = 8192, NPOOLROWS = 2560 * 128;
constexpr int SCS_LD = 2112, NKS = PAST + DSEQ;
constexpr float EPS = 1e-6f;
constexpr size_t O_Y = 0, O_KP = 17825792, O_VP = 22020096, O_IKP = 26214400, O_CVP = 26738688, O_SSP = 26757120,
                 O_KS = 27281408, O_VS = 27543552, O_IKS = 27805696, O_CVS = 27838464, O_SSS = 30197760, O_END = 97306624;
constexpr size_t MiB = 1u << 20;
constexpr size_t WS_CTL = 0, CTL_ZERO_BYTES = 1 * MiB;
constexpr size_t WS_WIN = 2 * MiB, WS_WPA = 76 * MiB, WS_WPS = 84 * MiB, WS_WOUT = 100 * MiB, WS_WUP = 108 * MiB, WS_WDN = 140 * MiB;
constexpr size_t WS_XN = 172 * MiB, WS_PROJ = 208 * MiB, WS_PF = 520 * MiB, WS_KB = 564 * MiB, WS_VB = 573 * MiB, WS_K8 = 564 * MiB, WS_V8 = 569 * MiB, WS_IKB = 582 * MiB, WS_IWB = 584 * MiB, WS_DTB = 585 * MiB;
constexpr size_t WS_XT = 588 * MiB  , WS_BROW = 652 * MiB  , WS_CROW = 668 * MiB  , WS_BT = 684 * MiB  , WS_XBS = 700 * MiB  ;
constexpr size_t WS_SC = 708 * MiB  , WS_SCS = 964 * MiB  , WS_SEL = 970 * MiB  , WS_CNT = 979 * MiB, WS_AO = 980 * MiB  ;
constexpr size_t WS_CS = 1016 * MiB  , WS_CSL = 1144 * MiB, WS_STIN = 1145 * MiB  , WS_SSMO = 1210 * MiB  ;
constexpr size_t WS_MIX32 = 1280 * MiB  , WS_MIXB = 1348 * MiB  , WS_H = 1384 * MiB  , WS_HN = 1452 * MiB  , WS_U = 1488 * MiB  , WS_END = 1626 * MiB;
constexpr size_t WS_QB = 1626 * MiB  , WS_IQB = 1660 * MiB  , WS_END2 = 1678 * MiB;
constexpr size_t WS_ROPE = 1678 * MiB  , WS_ROPE2 = 1683 * MiB, WS_END3 = 1686 * MiB;
constexpr int NPOS = TP + DSEQ;
constexpr int CW_BAR = 4096;
constexpr int LDS_BYTES = 147456, RING_BYTES = 131072, CTL_OFF = 139264, MISC_OFF = CTL_OFF + 320;

struct Params {
    const float* in[26]; float* out; unsigned char* ws; int ph_lo, ph_hi;
};

#define LDS_WAIT() asm volatile("s_waitcnt lgkmcnt(0)" ::: "memory")
#define VM_WAIT() asm volatile("s_waitcnt vmcnt(0)" ::: "memory")
#define MFMA16S(a, b, c) __builtin_amdgcn_mfma_f32_16x16x32_bf16((a), (b), (c), 0, 0, 0)
__device__ __forceinline__ unsigned pk2(float lo, float hi) { return pg8::cvt_pk_bf16(lo, hi); }
__device__ __forceinline__ float bf_lo(unsigned w) { return __uint_as_float(w << 16); }
__device__ __forceinline__ float bf_hi(unsigned w) { return __uint_as_float(w & 0xffff0000u); }
__device__ __forceinline__ float bf1(bf16 b) { return __uint_as_float(((unsigned)b) << 16); }
__device__ __forceinline__ float sigmoidf_(float x) { return __builtin_amdgcn_rcpf(1.f + __expf(-x)); }
__device__ __forceinline__ float siluf_(float x) { return x * __builtin_amdgcn_rcpf(1.f + __expf(-x)); }
__device__ __forceinline__ float wave_sum(float v) {
#pragma unroll
    for (int o = 1; o < 64; o <<= 1) v += __shfl_xor(v, o);
    return v;
}
#define DPP_F(x, ctrl) __int_as_float(__builtin_amdgcn_update_dpp(0, __float_as_int(x), (ctrl), 0xf, 0xf, false))
__device__ __forceinline__ float sum16(float x) { x += DPP_F(x, 0x128); x += DPP_F(x, 0x124); x += DPP_F(x, 0x122); x += DPP_F(x, 0x121); return x; }
__device__ __forceinline__ float sum4(float x) { x += DPP_F(x, 0xB1); x += DPP_F(x, 0x4E); return x; }
__device__ __forceinline__ float sum2(float x) { x += DPP_F(x, 0xB1); return x; }
__device__ __forceinline__ const float* xrow_ptr(const Params& p, int r) { return r < TP ? p.in[0] + (size_t)r * DM : p.in[1] + (size_t)(r - TP) * DM; }

struct LdNone {};
struct FIn {
    static constexpr bool WANT_SSQ = false; static constexpr int BATCH = 16; typedef LdNone Ld;
    bf16* P; float* F;
    __device__ __forceinline__ Ld load(int, int) const { return Ld{}; }
    __device__ __forceinline__ float finish(int row, int col, f32x4 v0, f32x4 v1, const Ld&, int ctile) const {
        if ((ctile >= 8 && ctile < 12) || ctile == 16) { float* rp = F + (size_t)row * PF_LD + (ctile == 16 ? 1024 + col - C_IK : col - C_K); *(f32x4*)rp = v0; *(f32x4*)(rp + 4) = v1; }
        else { v4u w; w.x = pk2(v0[0], v0[1]); w.y = pk2(v0[2], v0[3]); w.z = pk2(v1[0], v1[1]); w.w = pk2(v1[2], v1[3]); *(v4u*)(P + (size_t)row * NIN + col) = w; }
        return 0.f;
    }
};
struct LdG { v4u g; };
struct FPA {
    static constexpr bool WANT_SSQ = false; static constexpr int BATCH = 16; typedef LdG Ld;
    const bf16* P; bf16* MX;
    __device__ __forceinline__ Ld load(int row, int col) const { return Ld{*(const v4u*)(P + (size_t)row * NIN + C_GA + col)}; }
    __device__ __forceinline__ float finish(int row, int col, f32x4 v0, f32x4 v1, const Ld& ld, int) const {
        const v4u g = ld.g; v4u w;
        w.x = pk2(sigmoidf_(bf_lo(g.x)) * v0[0], sigmoidf_(bf_hi(g.x)) * v0[1]); w.y = pk2(sigmoidf_(bf_lo(g.y)) * v0[2], sigmoidf_(bf_hi(g.y)) * v0[3]);
        w.z = pk2(sigmoidf_(bf_lo(g.z)) * v1[0], sigmoidf_(bf_hi(g.z)) * v1[1]); w.w = pk2(sigmoidf_(bf_lo(g.w)) * v1[2], sigmoidf_(bf_hi(g.w)) * v1[3]);
        *(v4u*)(MX + (size_t)row * DM + col) = w;
        return 0.f;
    }
};
struct LdGM { v4u g; v4u a; };
struct FPS {
    static constexpr bool WANT_SSQ = false; static constexpr int BATCH = 8; typedef LdGM Ld;
    const bf16* P; const bf16* MX; bf16* MB;
    __device__ __forceinline__ Ld load(int row, int col) const { return Ld{*(const v4u*)(P + (size_t)row * NIN + C_GB + col), *(const v4u*)(MX + (size_t)row * DM + col)}; }
    __device__ __forceinline__ float finish(int row, int col, f32x4 v0, f32x4 v1, const Ld& ld, int) const {
        const v4u g = ld.g, a = ld.a;
        v4u w;
        w.x = pk2(bf_lo(a.x) + sigmoidf_(bf_lo(g.x)) * v0[0], bf_hi(a.x) + sigmoidf_(bf_hi(g.x)) * v0[1]);
        w.y = pk2(bf_lo(a.y) + sigmoidf_(bf_lo(g.y)) * v0[2], bf_hi(a.y) + sigmoidf_(bf_hi(g.y)) * v0[3]);
        w.z = pk2(bf_lo(a.z) + sigmoidf_(bf_lo(g.z)) * v1[0], bf_hi(a.z) + sigmoidf_(bf_hi(g.z)) * v1[1]);
        w.w = pk2(bf_lo(a.w) + sigmoidf_(bf_lo(g.w)) * v1[2], bf_hi(a.w) + sigmoidf_(bf_hi(g.w)) * v1[3]);
        *(v4u*)(MB + (size_t)row * DM + col) = w;
        return 0.f;
    }
};
template <bool S_> struct LdR;
template <> struct LdR<true> { f32x4 x0, x1; };
template <> struct LdR<false> { v4u h; };
template <bool SSQ_>
struct FRes {
    static constexpr bool WANT_SSQ = SSQ_; static constexpr int BATCH = 8; typedef LdR<SSQ_> Ld;
    const float* b0; const float* b1; const bf16* hb; float* O; bf16* HB;
    __device__ __forceinline__ Ld load(int row, int col) const {
        if constexpr (SSQ_) { const float* bp = (row < TP ? b0 + (size_t)row * DM : b1 + (size_t)(row - TP) * DM) + col; return Ld{*(const f32x4*)bp, *(const f32x4*)(bp + 4)}; }
        else return Ld{*(const v4u*)(hb + (size_t)row * DM + col)};
    }
    __device__ __forceinline__ float finish(int row, int col, f32x4 v0, f32x4 v1, const Ld& ld, int) const {
        if constexpr (!SSQ_) {
            const v4u h = ld.h; float* op = O + (size_t)row * DM + col;
            *(f32x4*)op = (f32x4){bf_lo(h.x) + v0[0], bf_hi(h.x) + v0[1], bf_lo(h.y) + v0[2], bf_hi(h.y) + v0[3]};
            *(f32x4*)(op + 4) = (f32x4){bf_lo(h.z) + v1[0], bf_hi(h.z) + v1[1], bf_lo(h.w) + v1[2], bf_hi(h.w) + v1[3]};
            return 0.f;
        } else {
            const f32x4 x0 = ld.x0 + v0, x1 = ld.x1 + v1;
            v4u hw; hw.x = pk2(x0[0], x0[1]); hw.y = pk2(x0[2], x0[3]); hw.z = pk2(x1[0], x1[1]); hw.w = pk2(x1[2], x1[3]);
            *(v4u*)(HB + (size_t)row * DM + col) = hw;
            return ((x0[0] * x0[0] + x0[1] * x0[1]) + (x0[2] * x0[2] + x0[3] * x0[3])) + ((x1[0] * x1[0] + x1[1] * x1[1]) + (x1[2] * x1[2] + x1[3] * x1[3]));
        }
    }
};
struct LdS { float s; };
struct FUp {
    static constexpr bool WANT_SSQ = false; static constexpr int BATCH = 16; typedef LdS Ld;
    bf16* U; const float* ssq;
    __device__ __forceinline__ Ld load(int row, int) const { return Ld{ssq[row]}; }
    __device__ __forceinline__ float finish(int row, int col, f32x4 v0, f32x4 v1, const Ld& ld, int) const {
        const float rs = rsqrtf(ld.s * (1.f / DM) + EPS);
#pragma unroll
        for (int j = 0; j < 4; ++j) { const float a = fmaxf(v0[j] * rs, 0.f), b = fmaxf(v1[j] * rs, 0.f); v0[j] = a * a; v1[j] = b * b; }
        v4u w; w.x = pk2(v0[0], v0[1]); w.y = pk2(v0[2], v0[3]); w.z = pk2(v1[0], v1[1]); w.w = pk2(v1[2], v1[3]);
        *(v4u*)(U + (size_t)row * DFF + col) = w;
        return 0.f;
    }
};
template <class F> struct BigEpi {
    static constexpr bool PERM = true, AFTER_DRAIN = false;
    F f; int row_off; float* ssq;
    __device__ __forceinline__ void operator()(const pg8::f32x4 (&acc)[2][2][4][2], const pg8::Unit& u, int wr, int wc, int fr, int fq) const {
        const int row0 = row_off + u.pm * 256 + wr * 64 + fr, c0 = u.pn * 256 + wc * 32 + 8 * fq, ctile = u.pn;
        constexpr int NBT = F::BATCH;
#pragma unroll
        for (int q0 = 0; q0 < 16; q0 += NBT) {
            typename F::Ld ld[NBT];
#pragma unroll
            for (int k = 0; k < NBT; ++k) { const int q = q0 + k; ld[k] = f.load(row0 + (q >> 3) * 128 + ((q >> 1) & 3) * 16, c0 + (q & 1) * 128); }
#pragma unroll
            for (int k = 0; k < NBT; k += 2) {
                const int q = q0 + k, ai = q >> 3, m = (q >> 1) & 3, row = row0 + ai * 128 + m * 16;
                float s = f.finish(row, c0, acc[ai][0][m][0], acc[ai][0][m][1], ld[k], ctile);
                s += f.finish(row, c0 + 128, acc[ai][1][m][0], acc[ai][1][m][1], ld[k + 1], ctile);
                if (F::WANT_SSQ) { s += __shfl_xor(s, 16); s += __shfl_xor(s, 32); if (fq == 0) atomicAdd(ssq + row, s); }
            }
        }
    }
};
__device__ __forceinline__ unsigned sg_off(unsigned row, unsigned ch) { return row * 128u + ((ch ^ (row & 7u)) << 4); }
template <class F>
__device__ __forceinline__ void gemm_small(LAS unsigned char* lds, const bf16* A, const bf16* Bt, int Ms, int N, int K, const F& f, int row_off, float* ssq, int G, int blk, int wave, int lane) {
    const int tid = wave * 64 + lane, nMt = Ms / 64, total = nMt * (N / 64), nk = K / 64;
    const int lrow = tid >> 3, lch = tid & 7;
    const int ti = wave >> 1, tj0 = 2 * (wave & 1), r = lane & 15, kq = lane >> 4;
    LAS float* ct = (LAS float*)(lds + 32768);
    for (int t = blk; t < total; t += G) {
        const int tn = t / nMt, tm = t - tn * nMt;
        const bf16* ap = A + (size_t)(tm * 64 + lrow) * K + 8 * lch; const bf16* bp = Bt + (size_t)(tn * 64 + lrow) * K + 8 * lch;
        v4u ra[4], rb[4];
#pragma unroll
        for (int d = 0; d < 4; ++d) { if (d < nk) { ra[d] = *(const v4u*)(ap + 64 * d); rb[d] = *(const v4u*)(bp + 64 * d); } }
        f32x4 acc0 = (f32x4){0.f, 0.f, 0.f, 0.f}, acc1 = (f32x4){0.f, 0.f, 0.f, 0.f};
        for (int s0 = 0; s0 < nk; s0 += 4) {
#pragma unroll
            for (int d = 0; d < 4; ++d) {
                const int s = s0 + d;
                LAS unsigned char* st = lds + (d & 1) * 16384;
                *(LAS v4u*)(st + sg_off(lrow, lch)) = ra[d]; *(LAS v4u*)(st + 8192 + sg_off(lrow, lch)) = rb[d];
                if (s + 4 < nk) { ra[d] = *(const v4u*)(ap + 64 * (s + 4)); rb[d] = *(const v4u*)(bp + 64 * (s + 4)); }
                __syncthreads();
#pragma unroll
                for (int ks = 0; ks < 2; ++ks) {
                    const bf16x8 af = *(const LAS bf16x8*)(st + sg_off(16 * ti + r, 4 * ks + kq));
                    const bf16x8 b0 = *(const LAS bf16x8*)(st + 8192 + sg_off(16 * tj0 + r, 4 * ks + kq));
                    const bf16x8 b1 = *(const LAS bf16x8*)(st + 8192 + sg_off(16 * tj0 + 16 + r, 4 * ks + kq));
                    acc0 = MFMA16S(af, b0, acc0); acc1 = MFMA16S(af, b1, acc1);
                }
            }
        }
#pragma unroll
        for (int i = 0; i < 4; ++i) { ct[(16 * ti + 4 * kq + i) * 68 + 16 * tj0 + r] = acc0[i]; ct[(16 * ti + 4 * kq + i) * 68 + 16 * tj0 + 16 + r] = acc1[i]; }
        __syncthreads();
        { const f32x4 v0 = *(const LAS f32x4*)(ct + lrow * 68 + 8 * lch), v1 = *(const LAS f32x4*)(ct + lrow * 68 + 8 * lch + 4);
          const typename F::Ld ld_ = f.load(row_off + tm * 64 + lrow, tn * 64 + 8 * lch);
          float sq_ = f.finish(row_off + tm * 64 + lrow, tn * 64 + 8 * lch, v0, v1, ld_, (tn * 64) >> 8);
          if (F::WANT_SSQ) { sq_ += __shfl_xor(sq_, 1); sq_ += __shfl_xor(sq_, 2); sq_ += __shfl_xor(sq_, 4); if (lch == 0) atomicAdd(ssq + row_off + tm * 64 + lrow, sq_); } }
        __syncthreads();
    }
}
#define XB_TMO      128
#define XB_XCNT(j)  (256  + 64 * (j))
#define XB_XSUB(j)  (1280 + 64 * (j))
#define XB_XGEN(j)  (2304 + 64 * (j))
#define XB_TOP      3328
#define XB_TOPGEN   3392
#define XCD_BAR_WORDS 3456
#define XB_SPIN_CAP (1u << 18)

__device__ __forceinline__ unsigned xb_ld(unsigned* p)              { return __hip_atomic_load(p, __ATOMIC_RELAXED, __HIP_MEMORY_SCOPE_AGENT); }
__device__ __forceinline__ unsigned xb_add(unsigned* p, unsigned v) { return __hip_atomic_fetch_add(p, v, __ATOMIC_RELAXED, __HIP_MEMORY_SCOPE_AGENT); }
__device__ __forceinline__ unsigned xb_xcc_id() { return (unsigned)__builtin_amdgcn_s_getreg((3 << 11) | 20) & 0xFu; }
#define XB_SPIN(cond, bar) do { unsigned _sp = 0; while (cond) { __builtin_amdgcn_s_sleep(1); \
    if ((++_sp & 255u) == 0u) { if (xb_ld(&(bar)[XB_TMO])) break; if (_sp > XB_SPIN_CAP) { atomicAdd(&(bar)[XB_TMO], 1u); break; } } } } while (0)

struct XcdBarrier {
    unsigned* bar; unsigned x;
    volatile LAS unsigned* st;
};

__device__ __forceinline__ XcdBarrier xcd_barrier_post(unsigned* bar, volatile LAS unsigned* st) {
    XcdBarrier b; b.bar = bar; b.x = xb_xcc_id(); b.st = st;
    if (threadIdx.x == 0) (void)xb_add(&bar[XB_XCNT(b.x)], 1u);
    return b;
}
__device__ __forceinline__ void xcd_barrier_complete(unsigned* bar, unsigned x, unsigned& nloc, unsigned& nx) {
    const unsigned G = gridDim.x * gridDim.y * gridDim.z;
    unsigned sum, cnt, mine, sp = 0u;
    for (;;) {
        sum = 0u; cnt = 0u; mine = 0u;
#pragma unroll
        for (unsigned j = 0; j < 16; ++j) { const unsigned c = xb_ld(&bar[XB_XCNT(j)]); sum += c; cnt += (c > 0u) ? 1u : 0u; mine = (j == x) ? c : mine; }
        if (sum == G) break;
        __builtin_amdgcn_s_sleep(1);
        if ((++sp & 255u) == 0u) { if (xb_ld(&bar[XB_TMO])) break; if (sp > XB_SPIN_CAP) { atomicAdd(&bar[XB_TMO], 1u); break; } }
    }
    nloc = mine > 0u ? mine : 1u; nx = cnt > 0u ? cnt : 1u;
}

__device__ __forceinline__ void xcd_barrier(const XcdBarrier& b) {
    asm volatile("s_waitcnt vmcnt(0)" ::: "memory");
    __syncthreads();
    if (threadIdx.x == 0) {
        unsigned* bar = b.bar;
        __builtin_amdgcn_s_waitcnt(0);
        unsigned nloc = b.st[0], nx = b.st[1];
        if (nloc == 0u) { xcd_barrier_complete(bar, b.x, nloc, nx); b.st[0] = nloc; b.st[1] = nx; }
        const unsigned old = xb_add(&bar[XB_XSUB(b.x)], 1u);
        const unsigned gen = old / nloc;
        if (old + 1u == (gen + 1u) * nloc) {
            __builtin_amdgcn_fence(__ATOMIC_RELEASE, "agent");
            asm volatile("s_waitcnt vmcnt(0)" ::: "memory");
            const unsigned og = xb_add(&bar[XB_TOP], 1u);
            const unsigned tg = og / nx;
            if (og + 1u == (tg + 1u) * nx) xb_add(&bar[XB_TOPGEN], 1u);
            else XB_SPIN(xb_ld(&bar[XB_TOPGEN]) == tg, bar);
            __builtin_amdgcn_fence(__ATOMIC_ACQUIRE, "agent");
            xb_add(&bar[XB_XGEN(b.x)], 1u);
            asm volatile("s_waitcnt vmcnt(0)" ::: "memory");
        } else {
            XB_SPIN(xb_ld(&bar[XB_XGEN(b.x)]) == gen, bar);
            __builtin_amdgcn_fence(__ATOMIC_ACQUIRE, "agent");
            asm volatile("s_waitcnt vmcnt(0)" ::: "memory");
        }
    }
    __syncthreads();
}

constexpr float LOG2_THETA = 13.287712379549449f;
__device__ __forceinline__ int src_col_in(int nd) {
    if (nd < 4160) return nd;
    if (nd < 4224) return 14416 + (nd - 4160);
    if (nd < 4240) return 4160 + (nd - 4224);
    if (nd < 4352) return -1;
    if (nd < 8448) return 4176 + (nd - 4352);
    if (nd < 14592) return 8272 + (nd - 8448);
    if (nd < 16640) return 14480 + (nd - 14592);
    return 16528 + (nd - 16640);
}
struct TItem { const float* W; bf16* WT; const float* ks; int K, Nsrc, k0, n0; bool map; };
__device__ __forceinline__ void titem_load(const TItem& t, f32x4 (&v)[16], int lane) {
    const int nd = t.n0 + 4 * (lane & 15);
    const int sc = t.map ? src_col_in(nd) : nd;
#pragma unroll
    for (int i = 0; i < 16; ++i) { const int kk = (lane >> 4) + 4 * i;
        v[i] = (sc >= 0) ? *(const f32x4*)(t.W + (size_t)(t.k0 + kk) * t.Nsrc + sc) : (f32x4){0.f, 0.f, 0.f, 0.f}; }
}
__device__ __forceinline__ void titem_finish(const TItem& t, f32x4 (&v)[16], LAS float* scr, int lane) {
    if (t.ks) {
#pragma unroll
        for (int i = 0; i < 16; ++i) v[i] = v[i] * t.ks[t.k0 + (lane >> 4) + 4 * i];
    }
#pragma unroll
    for (int i = 0; i < 16; ++i) { const int kk = (lane >> 4) + 4 * i; LAS float* d = scr + kk * 65 + 4 * (lane & 15);
        d[0] = v[i][0]; d[1] = v[i][1]; d[2] = v[i][2]; d[3] = v[i][3]; }
    LDS_WAIT();
    const int c = lane & 7;
#pragma unroll
    for (int j = 0; j < 8; ++j) { const int n = (lane >> 3) + 8 * j; const LAS float* s = scr + (8 * c) * 65 + n;
        v4u o; o.x = pk2(s[0 * 65], s[1 * 65]); o.y = pk2(s[2 * 65], s[3 * 65]); o.z = pk2(s[4 * 65], s[5 * 65]); o.w = pk2(s[6 * 65], s[7 * 65]);
        *(v4u*)(t.WT + (size_t)(t.n0 + n) * t.K + t.k0 + 8 * c) = o; }
    LDS_WAIT();
}
__device__ __forceinline__ void rms_row_load(f32x4 (&v)[8], const float* xrow, int lane) {
#pragma unroll
    for (int j = 0; j < 8; ++j) v[j] = *(const f32x4*)(xrow + 4 * lane + 256 * j);
}
__device__ __forceinline__ void rms_row_finish(const f32x4 (&v)[8], const float* g, bf16* orow, int lane) {
    float s = 0.f;
#pragma unroll
    for (int j = 0; j < 8; ++j) s += (v[j][0] * v[j][0] + v[j][1] * v[j][1]) + (v[j][2] * v[j][2] + v[j][3] * v[j][3]);
    const float r = rsqrtf(wave_sum(s) * (1.f / DM) + EPS);
#pragma unroll
    for (int j = 0; j < 8; ++j) { const f32x4 gg = *(const f32x4*)(g + 4 * lane + 256 * j);
        v2u o; o.x = pk2(v[j][0] * r * gg[0], v[j][1] * r * gg[1]); o.y = pk2(v[j][2] * r * gg[2], v[j][3] * r * gg[3]);
        *(v2u*)(orow + 4 * lane + 256 * j) = o; }
}
__device__ __forceinline__ void phase_prologue(const Params& p, LAS unsigned char* lds, int gw, int ngw, int wave, int lane) {
    LAS float* scr = (LAS float*)(lds + wave * 16640);
    unsigned char* ws = p.ws;
    constexpr int I_IN = (DM / 64) * (NIN / 64), I_PA = 32 * 32, I_PS = 64 * 32, I_OUT = 32 * 32, I_UP = 32 * 128, I_DN = 128 * 32;
    constexpr int NIT = I_IN + I_PA + I_PS + I_OUT + I_UP + I_DN;
    auto decode = [&](int it) -> TItem {
        int r = it; TItem t; t.ks = nullptr; t.map = false; int nblk;
        if (r < I_IN) { t.W = p.in[9]; t.K = DM; t.Nsrc = NIN_SRC; t.WT = (bf16*)(ws + WS_WIN); nblk = NIN / 64; t.map = true; }
        else if ((r -= I_IN) < I_PA) { t.W = p.in[20]; t.K = DM; t.Nsrc = DM; t.WT = (bf16*)(ws + WS_WPA); nblk = DM / 64; }
        else if ((r -= I_PA) < I_PS) { t.W = p.in[21]; t.K = DI; t.Nsrc = DM; t.WT = (bf16*)(ws + WS_WPS); nblk = DM / 64; }
        else if ((r -= I_PS) < I_OUT) { t.W = p.in[22]; t.K = DM; t.Nsrc = DM; t.WT = (bf16*)(ws + WS_WOUT); nblk = DM / 64; }
        else if ((r -= I_OUT) < I_UP) { t.W = p.in[24]; t.K = DM; t.Nsrc = DFF; t.WT = (bf16*)(ws + WS_WUP); nblk = DFF / 64; t.ks = p.in[23]; }
        else { r -= I_UP; t.W = p.in[25]; t.K = DFF; t.Nsrc = DM; t.WT = (bf16*)(ws + WS_WDN); nblk = DM / 64; }
        const int kb = r / nblk; t.k0 = kb * 64; t.n0 = (r - kb * nblk) * 64; return t;
    };
    if (gw < NIT) {
        f32x4 va[16], vb[16];
        TItem ta = decode(gw), tb = ta;
        titem_load(ta, va, lane);
        for (int it = gw; it < NIT; it += 2 * ngw) {
            const bool hb = it + ngw < NIT;
            if (hb) { tb = decode(it + ngw); titem_load(tb, vb, lane); }
            titem_finish(ta, va, scr, lane);
            if (!hb) break;
            const bool ha = it + 2 * ngw < NIT;
            if (ha) { ta = decode(it + 2 * ngw); titem_load(ta, va, lane); }
            titem_finish(tb, vb, scr, lane);
        }
    }
    if (gw < MT) {
        f32x4 cv_[8], nv_[8];
        rms_row_load(cv_, xrow_ptr(p, gw), lane);
        for (int m = gw; m < MT; m += ngw) {
            const int mn = m + ngw;
#pragma unroll
            for (int j = 0; j < 8; ++j) nv_[j] = cv_[j];
            if (mn < MT) rms_row_load(nv_, xrow_ptr(p, mn), lane);
            rms_row_finish(cv_, p.in[8], (bf16*)(ws + WS_XN) + (size_t)m * DM, lane);
#pragma unroll
            for (int j = 0; j < 8; ++j) cv_[j] = nv_[j];
        }
    }
    for (int pr = gw; pr < NPOS; pr += ngw) {
        const float fpos = (float)(pr < TP ? pr : PAST + (pr - TP));
        const float a = fpos * exp2f(-(float)lane * (LOG2_THETA / 64.f));
        *(f32x2*)((float*)(ws + WS_ROPE) + ((size_t)pr * 64 + lane) * 2) = (f32x2){cosf(a), sinf(a)};
        if (lane < 32) { const float b = fpos * exp2f(-(float)lane * (LOG2_THETA / 32.f)); *(f32x2*)((float*)(ws + WS_ROPE2) + ((size_t)pr * 32 + lane) * 2) = (f32x2){cosf(b), sinf(b)}; }
    }
}

__device__ __forceinline__ void p2_row(const Params& p, int r, int lane) {
    unsigned char* ws = p.ws;
    bf16* prow = (bf16*)(ws + WS_PROJ) + (size_t)r * NIN;
    const float* frow = (const float*)(ws + WS_PF) + (size_t)r * PF_LD;
    const int prow_ = r < TP ? r : TP + ((r - TP) & 3);
    {
        const int hq = lane >> 2, pq = lane & 3;
        const float* g = p.in[10]; const float* tb = (const float*)(ws + WS_ROPE) + (size_t)prow_ * 128;
        v4u w[2][2];
#pragma unroll
        for (int a_ = 0; a_ < 2; ++a_)
#pragma unroll
            for (int b_ = 0; b_ < 2; ++b_) w[a_][b_] = *(const v4u*)(prow + C_Q + hq * 128 + 64 * b_ + 8 * (pq + 4 * a_));
        float x[2][2][8]; float ss = 0.f;
#pragma unroll
        for (int a_ = 0; a_ < 2; ++a_)
#pragma unroll
            for (int b_ = 0; b_ < 2; ++b_) { const unsigned ww[4] = {w[a_][b_].x, w[a_][b_].y, w[a_][b_].z, w[a_][b_].w};
#pragma unroll
                for (int j = 0; j < 4; ++j) { x[a_][b_][2 * j] = bf_lo(ww[j]); x[a_][b_][2 * j + 1] = bf_hi(ww[j]); ss += x[a_][b_][2 * j] * x[a_][b_][2 * j] + x[a_][b_][2 * j + 1] * x[a_][b_][2 * j + 1]; } }
        ss = sum4(ss);
        const float rr = rsqrtf(ss * (1.f / 128.f) + EPS);
        bf16* qo = (bf16*)(ws + WS_QB) + (size_t)r * DM + hq * 128;
#pragma unroll
        for (int a_ = 0; a_ < 2; ++a_) {
            const int i8 = 8 * (pq + 4 * a_);
            float o1[8], o2[8];
#pragma unroll
            for (int q4 = 0; q4 < 2; ++q4) {
                const f32x4 ga = *(const f32x4*)(g + i8 + 4 * q4), gb = *(const f32x4*)(g + 64 + i8 + 4 * q4);
                const f32x4 t0_ = *(const f32x4*)(tb + (i8 + 4 * q4) * 2), t1_ = *(const f32x4*)(tb + (i8 + 4 * q4) * 2 + 4);
                const float cc[4] = {t0_[0], t0_[2], t1_[0], t1_[2]}, sn[4] = {t0_[1], t0_[3], t1_[1], t1_[3]};
#pragma unroll
                for (int e = 0; e < 4; ++e) { const float x1 = x[a_][0][4 * q4 + e] * rr * ga[e], x2 = x[a_][1][4 * q4 + e] * rr * gb[e];
                    o1[4 * q4 + e] = x1 * cc[e] - x2 * sn[e]; o2[4 * q4 + e] = x2 * cc[e] + x1 * sn[e]; }
            }
            v4u u1, u2; u1.x = pk2(o1[0], o1[1]); u1.y = pk2(o1[2], o1[3]); u1.z = pk2(o1[4], o1[5]); u1.w = pk2(o1[6], o1[7]);
            u2.x = pk2(o2[0], o2[1]); u2.y = pk2(o2[2], o2[3]); u2.z = pk2(o2[4], o2[5]); u2.w = pk2(o2[6], o2[7]);
            *(v4u*)(qo + i8) = u1; *(v4u*)(qo + 64 + i8) = u2;
        }
    }
    float* outk = p.out + (r < TP ? O_KP + (size_t)r * 512 : O_KS + (size_t)(r - TP) * 512);
    float* outv = p.out + (r < TP ? O_VP + (size_t)r * 512 : O_VS + (size_t)(r - TP) * 512);
    {
        const int hk = lane >> 4, i4 = 4 * (lane & 15);
        const float* g = p.in[11]; const float* tb = (const float*)(ws + WS_ROPE) + (size_t)prow_ * 128;
        const f32x4 xa = *(const f32x4*)(frow + PF_K + hk * 128 + i4), xb = *(const f32x4*)(frow + PF_K + hk * 128 + 64 + i4);
        float ss = ((xa[0] * xa[0] + xa[1] * xa[1]) + (xa[2] * xa[2] + xa[3] * xa[3])) + ((xb[0] * xb[0] + xb[1] * xb[1]) + (xb[2] * xb[2] + xb[3] * xb[3]));
        ss = sum16(ss);
        const float rr = rsqrtf(ss * (1.f / 128.f) + EPS);
        const f32x4 ga = *(const f32x4*)(g + i4), gb = *(const f32x4*)(g + 64 + i4);
        const f32x4 t0_ = *(const f32x4*)(tb + i4 * 2), t1_ = *(const f32x4*)(tb + i4 * 2 + 4);
        const float cc[4] = {t0_[0], t0_[2], t1_[0], t1_[2]}, sn[4] = {t0_[1], t0_[3], t1_[1], t1_[3]};
        f32x4 o1, o2;
#pragma unroll
        for (int e = 0; e < 4; ++e) { const float x1 = xa[e] * rr * ga[e], x2 = xb[e] * rr * gb[e]; o1[e] = x1 * cc[e] - x2 * sn[e]; o2[e] = x2 * cc[e] + x1 * sn[e]; }
        *(f32x4*)(outk + hk * 128 + i4) = o1; *(f32x4*)(outk + hk * 128 + 64 + i4) = o2;
        if (r < TP) { unsigned char* k8 = ws + WS_K8 + (size_t)r * 512 + hk * 128 + i4;
            int w1 = __builtin_amdgcn_cvt_pk_fp8_f32(o1[0], o1[1], 0, false); w1 = __builtin_amdgcn_cvt_pk_fp8_f32(o1[2], o1[3], w1, true);
            int w2 = __builtin_amdgcn_cvt_pk_fp8_f32(o2[0], o2[1], 0, false); w2 = __builtin_amdgcn_cvt_pk_fp8_f32(o2[2], o2[3], w2, true);
            *(int*)k8 = w1; *(int*)(k8 + 64) = w2; }
    }
    {
#pragma unroll
        for (int j = 0; j < 2; ++j) { const int off = 4 * lane + 256 * j; const f32x4 v = *(const f32x4*)(frow + PF_V + off);
            *(f32x4*)(outv + off) = v;
            if (r < TP) { int w = __builtin_amdgcn_cvt_pk_fp8_f32(v[0], v[1], 0, false); w = __builtin_amdgcn_cvt_pk_fp8_f32(v[2], v[3], w, true); *(int*)(ws + WS_V8 + (size_t)r * 512 + off) = w; } }
    }
    const int j0 = 2 * (lane & 15);
    const f32x4 dt01 = *(const f32x4*)((const float*)(ws + WS_ROPE2) + ((size_t)prow_ * 32 + j0) * 2);
    const float d0 = dt01[0], t0 = dt01[1], d1 = dt01[2], t1 = dt01[3];
    {
        const int hi_ = lane >> 2, pq = lane & 3;
        const float* tb = (const float*)(ws + WS_ROPE2) + (size_t)prow_ * 64;
        const v4u w1 = *(const v4u*)(prow + C_IQ + hi_ * 64 + 8 * pq), w2 = *(const v4u*)(prow + C_IQ + hi_ * 64 + 32 + 8 * pq);
        const unsigned a4[4] = {w1.x, w1.y, w1.z, w1.w}, b4[4] = {w2.x, w2.y, w2.z, w2.w};
        unsigned u1[4], u2[4];
#pragma unroll
        for (int j = 0; j < 4; ++j) { const f32x4 t = *(const f32x4*)(tb + (8 * pq + 2 * j) * 2);
            const float x0 = bf_lo(a4[j]), x1 = bf_hi(a4[j]), y0 = bf_lo(b4[j]), y1 = bf_hi(b4[j]);
            u1[j] = pk2(x0 * t[0] - y0 * t[1], x1 * t[2] - y1 * t[3]); u2[j] = pk2(y0 * t[0] + x0 * t[1], y1 * t[2] + x1 * t[3]); }
        bf16* io = (bf16*)(ws + WS_IQB) + (size_t)r * 1024 + hi_ * 64 + 8 * pq;
        *(v4u*)io = (v4u){u1[0], u1[1], u1[2], u1[3]}; *(v4u*)(io + 32) = (v4u){u2[0], u2[1], u2[2], u2[3]};
    }
    {
        const f32x2 xa = *(const f32x2*)(frow + PF_IK + j0), xb = *(const f32x2*)(frow + PF_IK + 32 + j0);
        float s = (xa[0] + xa[1]) + (xb[0] + xb[1]);
        s = sum16(s);
        const float mean = s * (1.f / 64.f);
        const float e0 = xa[0] - mean, e1 = xa[1] - mean, e2 = xb[0] - mean, e3 = xb[1] - mean;
        float q = (e0 * e0 + e1 * e1) + (e2 * e2 + e3 * e3);
        q = sum16(q);
        const float rs = rsqrtf(q * (1.f / 64.f) + EPS);
        const float* g = p.in[12]; const float* b = p.in[13];
        const float x0 = e0 * rs * g[j0] + b[j0], x1 = e1 * rs * g[j0 + 1] + b[j0 + 1], y0 = e2 * rs * g[32 + j0] + b[32 + j0], y1 = e3 * rs * g[33 + j0] + b[33 + j0];
        const float o0 = x0 * d0 - y0 * t0, o1 = x1 * d1 - y1 * t1, o2 = y0 * d0 + x0 * t0, o3 = y1 * d1 + x1 * t1;
        if (lane < 16) {
            float* oi = p.out + (r < TP ? O_IKP + (size_t)r * 64 : O_IKS + (size_t)(r - TP) * 64);
            *(f32x2*)(oi + j0) = (f32x2){o0, o1}; *(f32x2*)(oi + 32 + j0) = (f32x2){o2, o3};
            bf16* ib = (bf16*)(ws + WS_IKB) + (size_t)r * 64;
            *(unsigned*)(ib + j0) = pk2(o0, o1); *(unsigned*)(ib + 32 + j0) = pk2(o2, o3);
        }
    }
    if (lane < 16) ((float*)(ws + WS_IWB))[(size_t)r * 16 + lane] = frow[PF_IW + lane] * (1.f / 32.f);
    {
        const float x = frow[PF_DT + lane] + p.in[16][lane];
        ((float*)(ws + WS_DTB))[(size_t)r * 64 + lane] = fmaxf(x, 0.f) + log1pf(expf(-fabsf(x)));
    }
}
constexpr int CONV_TOK = 16;
__device__ __forceinline__ void conv_unit_prompt(const Params& p, int unit, LAS unsigned char* stg  , int lane) {
    unsigned char* ws = p.ws;
    const int tb = unit / 12, slab = unit - tb * 12, tbase = tb * CONV_TOK, ch0 = slab * 512 + 8 * lane;
    const bf16* xb = (const bf16*)(ws + WS_PROJ) + C_XBC + ch0;
    float cw[4][8], cb[8];
#pragma unroll
    for (int i = 0; i < 4; ++i) { const f32x4 a = *(const f32x4*)(p.in[14] + (size_t)i * CONVD + ch0), b = *(const f32x4*)(p.in[14] + (size_t)i * CONVD + ch0 + 4);
        cw[i][0] = a[0]; cw[i][1] = a[1]; cw[i][2] = a[2]; cw[i][3] = a[3]; cw[i][4] = b[0]; cw[i][5] = b[1]; cw[i][6] = b[2]; cw[i][7] = b[3]; }
    { const f32x4 a = *(const f32x4*)(p.in[15] + ch0), b = *(const f32x4*)(p.in[15] + ch0 + 4);
      cb[0] = a[0]; cb[1] = a[1]; cb[2] = a[2]; cb[3] = a[3]; cb[4] = b[0]; cb[5] = b[1]; cb[6] = b[2]; cb[7] = b[3]; }
#define UNPK(dst, WW) do { dst[0] = bf_lo((WW)[0]); dst[1] = bf_hi((WW)[0]); dst[2] = bf_lo((WW)[1]); dst[3] = bf_hi((WW)[1]); dst[4] = bf_lo((WW)[2]); dst[5] = bf_hi((WW)[2]); dst[6] = bf_lo((WW)[3]); dst[7] = bf_hi((WW)[3]); } while (0)
    v4u xr[11];
#pragma unroll
    for (int j = 0; j < 3; ++j) { const int t = tbase - 3 + j; xr[j] = (v4u){0u, 0u, 0u, 0u}; if (t >= 0) xr[j] = *(const v4u*)(xb + (size_t)t * NIN); }
    const int c = tbase >> 7;
#pragma unroll
    for (int j = 0; j < 8; ++j) xr[3 + j] = *(const v4u*)(xb + (size_t)(tbase + j) * NIN);
#pragma unroll 1
    for (int sb = 0; sb < CONV_TOK / 8; ++sb) {
        const int t0 = tbase + 8 * sb, sl = t0 & 127;
        v4u xn[8];
        const int tn = (sb < CONV_TOK / 8 - 1) ? t0 + 8 : t0;
#pragma unroll
        for (int j = 0; j < 8; ++j) xn[j] = *(const v4u*)(xb + (size_t)(tn + j) * NIN);
        if (t0 == TP - 8) {
#pragma unroll
            for (int j = 0; j < 3; ++j) { float x[8]; UNPK(x, xr[8 + j]); float* o = p.out + O_CVP + (size_t)j * CONVD + ch0;
                *(f32x4*)o = (f32x4){x[0], x[1], x[2], x[3]}; *(f32x4*)(o + 4) = (f32x4){x[4], x[5], x[6], x[7]}; }
        }
        unsigned wt[8][4];
        v4u wr[8];
        float prev[8];
#pragma unroll
        for (int j = 0; j < 8; ++j) {
            float x0[8], x1[8], x2[8], x3[8], y[8];
            UNPK(x0, xr[j]); UNPK(x1, xr[j + 1]); UNPK(x2, xr[j + 2]); UNPK(x3, xr[j + 3]);
#pragma unroll
            for (int e = 0; e < 8; ++e) { const float a = cb[e] + (x0[e] * cw[0][e] + x1[e] * cw[1][e]) + (x2[e] * cw[2][e] + x3[e] * cw[3][e]); y[e] = siluf_(a); }
            wr[j].x = pk2(y[0], y[1]); wr[j].y = pk2(y[2], y[3]); wr[j].z = pk2(y[4], y[5]); wr[j].w = pk2(y[6], y[7]);
            if ((j & 1) == 0) {
#pragma unroll
                for (int e = 0; e < 8; ++e) prev[e] = y[e];
            } else {
#pragma unroll
                for (int e = 0; e < 8; ++e) wt[e][j >> 1] = pk2(prev[e], y[e]);
            }
        }
        const int h8 = (sl >> 3) & 1;
        if (ch0 < DI + 1024) {
            LAS unsigned char* tp = stg + (lane >> 2) * 1024 + (8 * (lane & 3)) * 16 + 8 * h8;
#pragma unroll
            for (int e = 0; e < 8; ++e) { *(LAS v2u*)(tp + e * 16) = (v2u){wt[e][0], wt[e][1]}; *(LAS v2u*)(tp + (e + 32) * 16) = (v2u){wt[e][2], wt[e][3]}; }
        }
        if (ch0 >= DI && ch0 < DI + 1024) {
            const int nn = ch0 - DI, g_ = nn >> 7, nl = nn & 127;
            bf16* br = (bf16*)(ws + WS_BROW) + ((((size_t)(c * 8 + g_) * 4 + (sl >> 5)) * 8 + (nl >> 4)) * 64 + (sl & 31) + 32 * ((nl >> 3) & 1)) * 8;
#pragma unroll
            for (int j = 0; j < 8; ++j) *(v4u*)(br + (size_t)j * 8) = wr[j];
        } else if (ch0 >= DI + 1024) {
            const int nn = ch0 - DI - 1024, g_ = nn >> 7, nl = nn & 127;
            bf16* cr = (bf16*)(ws + WS_CROW) + ((((size_t)(c * 8 + g_) * 4 + (sl >> 5)) * 8 + (nl >> 4)) * 64 + (sl & 31) + 32 * ((nl >> 3) & 1)) * 8;
#pragma unroll
            for (int j = 0; j < 8; ++j) *(v4u*)(cr + (size_t)j * 8) = wr[j];
        }
        xr[0] = xr[8]; xr[1] = xr[9]; xr[2] = xr[10];
#pragma unroll
        for (int j = 0; j < 8; ++j) xr[3 + j] = xn[j];
    }
    if (ch0 < DI + 1024) {
        LDS_WAIT();
        const int sg = (tbase & 127) >> 4;
        bf16* dst = (slab < 8) ? (bf16*)(ws + WS_XT) + ((size_t)(c * 128 + slab * 16) * 8 + sg) * 512 : (bf16*)(ws + WS_BT) + ((size_t)(c * 32 + (slab - 8) * 16) * 8 + sg) * 512;
#pragma unroll
        for (int T = 0; T < 16; ++T) *(v4u*)(dst + (size_t)T * 8 * 512 + lane * 8) = *(const LAS v4u*)(stg + T * 1024 + lane * 16);
        LDS_WAIT();
    }
#undef UNPK
}
__device__ __forceinline__ void conv_unit_sample(const Params& p, int unit, int lane) {
    unsigned char* ws = p.ws;
    const int b = unit / 12, slab = unit - b * 12, ch0 = slab * 512 + 8 * lane;
    v4u xr[7];
#pragma unroll
    for (int j = 0; j < 3; ++j) { const float* s = p.in[5] + ((size_t)b * 3 + j) * CONVD + ch0; const f32x4 a = *(const f32x4*)s, c = *(const f32x4*)(s + 4);
        xr[j].x = pk2(a[0], a[1]); xr[j].y = pk2(a[2], a[3]); xr[j].z = pk2(c[0], c[1]); xr[j].w = pk2(c[2], c[3]); }
    const bf16* xb = (const bf16*)(ws + WS_PROJ) + (size_t)(TP + 4 * b) * NIN + C_XBC + ch0;
#pragma unroll
    for (int j = 0; j < 4; ++j) xr[3 + j] = *(const v4u*)(xb + (size_t)j * NIN);
    float cw[4][8], cb[8];
#pragma unroll
    for (int i = 0; i < 4; ++i) { const f32x4 a = *(const f32x4*)(p.in[14] + (size_t)i * CONVD + ch0), c = *(const f32x4*)(p.in[14] + (size_t)i * CONVD + ch0 + 4);
        cw[i][0] = a[0]; cw[i][1] = a[1]; cw[i][2] = a[2]; cw[i][3] = a[3]; cw[i][4] = c[0]; cw[i][5] = c[1]; cw[i][6] = c[2]; cw[i][7] = c[3]; }
    { const f32x4 a = *(const f32x4*)(p.in[15] + ch0), c = *(const f32x4*)(p.in[15] + ch0 + 4);
      cb[0] = a[0]; cb[1] = a[1]; cb[2] = a[2]; cb[3] = a[3]; cb[4] = c[0]; cb[5] = c[1]; cb[6] = c[2]; cb[7] = c[3]; }
#define UNPK(dst, WW) do { dst[0] = bf_lo((WW)[0]); dst[1] = bf_hi((WW)[0]); dst[2] = bf_lo((WW)[1]); dst[3] = bf_hi((WW)[1]); dst[4] = bf_lo((WW)[2]); dst[5] = bf_hi((WW)[2]); dst[6] = bf_lo((WW)[3]); dst[7] = bf_hi((WW)[3]); } while (0)
#pragma unroll
    for (int j = 0; j < 3; ++j) { float x[8]; UNPK(x, xr[4 + j]); float* o = p.out + O_CVS + ((size_t)b * 3 + j) * CONVD + ch0;
        *(f32x4*)o = (f32x4){x[0], x[1], x[2], x[3]}; *(f32x4*)(o + 4) = (f32x4){x[4], x[5], x[6], x[7]}; }
    bf16* xo = (bf16*)(ws + WS_XBS) + (size_t)(4 * b) * CONVD + ch0;
#pragma unroll
    for (int j = 0; j < 4; ++j) { float x0[8], x1[8], x2[8], x3[8], y[8];
        UNPK(x0, xr[j]); UNPK(x1, xr[j + 1]); UNPK(x2, xr[j + 2]); UNPK(x3, xr[j + 3]);
#pragma unroll
        for (int e = 0; e < 8; ++e) { const float a = cb[e] + (x0[e] * cw[0][e] + x1[e] * cw[1][e]) + (x2[e] * cw[2][e] + x3[e] * cw[3][e]); y[e] = siluf_(a); }
        v4u w; w.x = pk2(y[0], y[1]); w.y = pk2(y[2], y[3]); w.z = pk2(y[4], y[5]); w.w = pk2(y[6], y[7]); *(v4u*)(xo + (size_t)j * CONVD) = w; }
#undef UNPK
}

__device__ __forceinline__ unsigned fkey(float f) { const unsigned u = __float_as_uint(f); return (u & 0x80000000u) ? ~u : (u | 0x80000000u); }
#define MFMA32(a, b, c) __builtin_amdgcn_mfma_f32_32x32x16_bf16((a), (b), (c), 0, 0, 0)
#define MFMA16(a, b, c) __builtin_amdgcn_mfma_f32_16x16x32_bf16((a), (b), (c), 0, 0, 0)
__device__ __forceinline__ float relu1(float x) { return __int_as_float(max(__float_as_int(x), 0)); }
__device__ __forceinline__ float wrelu16(const f32x16& acc, const f32x4 (&w)[4]) {
    f32x2 s0 = (f32x2){0.f, 0.f}, s1 = (f32x2){0.f, 0.f};
#pragma unroll
    for (int q = 0; q < 4; ++q) {
        const f32x2 r0 = (f32x2){relu1(acc[4 * q]), relu1(acc[4 * q + 1])}, r1 = (f32x2){relu1(acc[4 * q + 2]), relu1(acc[4 * q + 3])};
        s0 = (f32x2){w[q][0], w[q][1]} * r0 + s0; s1 = (f32x2){w[q][2], w[q][3]} * r1 + s1;
    }
    return (s0[0] + s0[1]) + (s1[0] + s1[1]);
}
__device__ __forceinline__ unsigned ik_off(unsigned row, unsigned pc) { return row * 128u + ((pc ^ (row & 7u)) << 4); }
__device__ __forceinline__ void score_unit_prompt(const Params& p, int unit, LAS unsigned char* kl  , int wave, int lane) {
    unsigned char* ws = p.ws;
    int j = 0; while (8 * (j + 1) * (j + 2) <= unit) ++j;
    const int v = unit - 8 * j * (j + 1), qb = 16 * j + v / (j + 1), kc = v % (j + 1);
    const int tw = 32 * qb + 4 * wave, r = lane & 31, hh = lane >> 5;
    const bf16* iqb = (const bf16*)(ws + WS_IQB);
    const float* iw = (const float*)(ws + WS_IWB);
    const bf16* ikb = (const bf16*)(ws + WS_IKB);
    int nkb = (32 * qb + 31 - 512 * kc) / 32 + 1; if (nkb > 16) nkb = 16;
    {
        const int tid = wave * 64 + lane, row0 = tid >> 3, pc = tid & 7;
        for (int rr = row0; rr < 32 * nkb; rr += 64) *(LAS v4u*)(kl + ik_off((unsigned)rr, (unsigned)pc)) = *(const v4u*)(ikb + (size_t)(512 * kc + rr) * 64 + 8 * pc);
    }
    bf16x8 af[2][4]; f32x4 wv[2][4];
#pragma unroll
    for (int rt = 0; rt < 2; ++rt) {
        const int tok = tw + 2 * rt + ((r >> 2) & 1), head = (r & 3) + 4 * (r >> 3);
#pragma unroll
        for (int kk = 0; kk < 4; ++kk) af[rt][kk] = *(const bf16x8*)(iqb + (size_t)tok * 1024 + head * 64 + 16 * kk + 8 * hh);
#pragma unroll
        for (int q = 0; q < 4; ++q) wv[rt][q] = *(const f32x4*)(iw + (size_t)(tw + 2 * rt + hh) * 16 + 4 * q);
    }
    LDS_WAIT();
    __syncthreads();
    unsigned* sc = (unsigned*)(ws + WS_SC);
    int nkt = (tw + 3 - 512 * kc) / 32 + 1; if (nkt > 16) nkt = 16;
#pragma unroll 2
    for (int kt = 0; kt < nkt; ++kt) {
        const int s0 = 512 * kc + 32 * kt;
        bf16x8 bf_[4];
#pragma unroll
        for (int kk = 0; kk < 4; ++kk) bf_[kk] = *(const LAS bf16x8*)(kl + ik_off((unsigned)(32 * kt + r), (unsigned)(2 * kk + hh)));
#pragma unroll
        for (int rt = 0; rt < 2; ++rt) {
            f32x16 acc;
#pragma unroll
            for (int i = 0; i < 16; ++i) acc[i] = 0.f;
#pragma unroll
            for (int kk = 0; kk < 4; ++kk) acc = MFMA32(af[rt][kk], bf_[kk], acc);
            const float s_ = wrelu16(acc, wv[rt]);
            sc[(size_t)(tw + 2 * rt + hh) * TP + s0 + r] = fkey(s_);
        }
    }
    __syncthreads();
}
__device__ __forceinline__ void score_job_sample(const Params& p, int job, int lane) {
    unsigned char* ws = p.ws;
    const int b = job / 13, ktg = job - b * 13, r = lane & 31, hh = lane >> 5;
    const bf16* proj = (const bf16*)(ws + WS_IQB);
    const float* iw = (const float*)(ws + WS_IWB);
    bf16x8 af[2][4]; f32x4 wv[2][4];
#pragma unroll
    for (int rt = 0; rt < 2; ++rt) {
        const int tok = TP + 4 * b + 2 * rt + ((r >> 2) & 1), head = (r & 3) + 4 * (r >> 3);
#pragma unroll
        for (int kk = 0; kk < 4; ++kk) af[rt][kk] = *(const bf16x8*)(proj + (size_t)tok * 1024 + head * 64 + 16 * kk + 8 * hh);
#pragma unroll
        for (int q = 0; q < 4; ++q) wv[rt][q] = *(const f32x4*)(iw + (size_t)(TP + 4 * b + 2 * rt + hh) * 16 + 4 * q);
    }
    const bf16* ikb = (const bf16*)(ws + WS_IKB);
    const int* pt = (const int*)p.in[7] + b * 16;
    unsigned* sc = (unsigned*)(ws + WS_SCS);
    f32x4 raw[8];
#define SCS_RAW(KT_) { const int key_ = 32 * (KT_) + r; const float* src_ = p.in[4] + ((size_t)pt[key_ >> 7] * 128 + (key_ & 127)) * 64 + 8 * hh; \
        _Pragma("unroll") for (int kk = 0; kk < 4; ++kk) { raw[2 * kk] = *(const f32x4*)(src_ + 16 * kk); raw[2 * kk + 1] = *(const f32x4*)(src_ + 16 * kk + 4); } }
    if (5 * ktg < 64) SCS_RAW(5 * ktg);
    for (int kt = 5 * ktg; kt < 5 * ktg + 5; ++kt) {
        const int key = 32 * kt + r;
        bf16x8 bfr[4];
        if (kt < 64) {
#pragma unroll
            for (int kk = 0; kk < 4; ++kk) { const f32x4 a = raw[2 * kk], c = raw[2 * kk + 1];
                v4u w; w.x = pk2(a[0], a[1]); w.y = pk2(a[2], a[3]); w.z = pk2(c[0], c[1]); w.w = pk2(c[2], c[3]); bfr[kk] = __builtin_bit_cast(bf16x8, w); }
            if (kt + 1 < 5 * ktg + 5 && kt + 1 < 64) SCS_RAW(kt + 1);
        } else if (key < NKS) {
#pragma unroll
            for (int kk = 0; kk < 4; ++kk) bfr[kk] = *(const bf16x8*)(ikb + (size_t)(TP + 4 * b + key - PAST) * 64 + 16 * kk + 8 * hh);
        } else {
#pragma unroll
            for (int kk = 0; kk < 4; ++kk) bfr[kk] = (bf16x8){0, 0, 0, 0, 0, 0, 0, 0};
        }
#pragma unroll
        for (int rt = 0; rt < 2; ++rt) {
            f32x16 acc;
#pragma unroll
            for (int i = 0; i < 16; ++i) acc[i] = 0.f;
#pragma unroll
            for (int kk = 0; kk < 4; ++kk) acc = MFMA32(af[rt][kk], bfr[kk], acc);
            const float s = wrelu16(acc, wv[rt]);
            if (key < NKS) sc[(size_t)(4 * b + 2 * rt + hh) * SCS_LD + key] = fkey(s);
        }
    }
}

template <bool SAMPLE>
__device__ __forceinline__ int sel_resolve(const int* pt, int b, int j) { if (!SAMPLE) return j; return j < PAST ? pt[j >> 7] * 128 + (j & 127) : (0x40000000 | (4 * b + j - PAST)); }
template <bool SAMPLE>
__device__ __forceinline__ void select_row_slow(const Params& p, int row, LAS unsigned* hist, int lane) {
    unsigned char* ws = p.ws;
    const int n = SAMPLE ? (PAST + 1 + ((row - TP) & 3)) : (row + 1);
    const int b = SAMPLE ? ((row - TP) >> 2) : 0;
    const unsigned* keys = SAMPLE ? (const unsigned*)(ws + WS_SCS) + (size_t)(row - TP) * SCS_LD : (const unsigned*)(ws + WS_SC) + (size_t)row * TP;
    const int* pt = (const int*)p.in[7] + b * 16;
    int* sel = (int*)(ws + WS_SEL) + (size_t)row * 256;
    int* cnt = (int*)(ws + WS_CNT) + row;
    if (n <= 256) {
        for (int i = 0; i < 4; ++i) { const int j = i * 64 + lane; sel[j] = sel_resolve<SAMPLE>(pt, b, j < n ? j : 0); }
        if (lane == 0) *cnt = n;
        return;
    }
    const int nch = (n + 63) >> 6;
    unsigned prefix = 0u, pmask = 0u; int need = 256;
    for (int level = 0; level < 4; ++level) {
        const int shift = level == 0 ? 22 : (level == 1 ? 12 : (level == 2 ? 2 : 0));
        const unsigned dm = level < 3 ? 1023u : 3u;
#pragma unroll
        for (int q = 0; q < 16; ++q) hist[q * 64 + lane] = 0u;
        LDS_WAIT();
#pragma unroll 4
        for (int i = 0; i < nch; ++i) { const int j = i * 64 + lane;
            if (j < n) { const unsigned k = keys[j];
                if ((k & pmask) == prefix) __hip_atomic_fetch_add(hist + ((k >> shift) & dm), 1u, __ATOMIC_RELAXED, __HIP_MEMORY_SCOPE_WORKGROUP); } }
        LDS_WAIT();
        unsigned h[16]; unsigned s = 0u;
#pragma unroll
        for (int q = 0; q < 16; ++q) { h[q] = hist[16 * lane + q]; s += h[q]; }
        unsigned S = s;
#pragma unroll
        for (int o = 1; o < 64; o <<= 1) { const unsigned t = __shfl_down(S, o); if (lane + o < 64) S += t; }
        const unsigned long long bal = __ballot(S >= (unsigned)need);
        const int L = 63 - __builtin_clzll(bal);
        unsigned cabove = S - s;
        int dsel = 0; unsigned csel = 0u; bool found = false;
#pragma unroll
        for (int q = 15; q >= 0; --q) { if (!found) { if (cabove + h[q] >= (unsigned)need) { dsel = 16 * lane + q; csel = cabove; found = true; } else cabove += h[q]; } }
        const int d = __shfl(dsel, L); const unsigned ca = __shfl(csel, L);
        need -= (int)ca; prefix |= ((unsigned)d) << shift; pmask |= dm << shift;
        LDS_WAIT();
    }
    const unsigned T = prefix;
    int pos = 0, eqtaken = 0;
    const unsigned long long lt = (1ull << lane) - 1ull;
#pragma unroll 2
    for (int i = 0; i < nch; ++i) {
        const int j = i * 64 + lane; const bool valid = j < n;
        const unsigned k = valid ? keys[j] : 0u;
        const bool gt = valid && k > T, eq = valid && k == T;
        const unsigned long long me = __ballot(eq);
        const bool esel = eq && (eqtaken + __popcll(me & lt) < need);
        const bool s_ = gt || esel;
        const unsigned long long ms = __ballot(s_);
        if (s_) sel[pos + __popcll(ms & lt)] = sel_resolve<SAMPLE>(pt, b, j);
        pos += __popcll(ms); eqtaken += __popcll(me);
    }
    if (lane == 0) *cnt = 256;
}

__device__ __forceinline__ int pfx(unsigned long long m) { return (int)__builtin_amdgcn_mbcnt_hi((unsigned)(m >> 32), __builtin_amdgcn_mbcnt_lo((unsigned)m, 0u)); }
__device__ __forceinline__ void find_digit(const LAS unsigned* hist, int need, int lane, int& d, unsigned& ca) {
    unsigned h[16]; unsigned s = 0u;
#pragma unroll
    for (int q = 0; q < 4; ++q) { const v4u t = *(const LAS v4u*)(hist + 16 * lane + 4 * q); h[4 * q] = t.x; h[4 * q + 1] = t.y; h[4 * q + 2] = t.z; h[4 * q + 3] = t.w; s += (t.x + t.y) + (t.z + t.w); }
    int P = (int)s;
    P += __builtin_amdgcn_update_dpp(0, P, 0x111, 0xf, 0xf, false); P += __builtin_amdgcn_update_dpp(0, P, 0x112, 0xf, 0xf, false);
    P += __builtin_amdgcn_update_dpp(0, P, 0x114, 0xf, 0xf, false); P += __builtin_amdgcn_update_dpp(0, P, 0x118, 0xf, 0xf, false);
    P += __builtin_amdgcn_update_dpp(0, P, 0x142, 0xa, 0xf, false); P += __builtin_amdgcn_update_dpp(0, P, 0x143, 0xc, 0xf, false);
    const unsigned S = (unsigned)__builtin_amdgcn_readlane(P, 63) - (unsigned)P + s;
    const unsigned long long bal = __ballot(S >= (unsigned)need);
    const int L = 63 - __builtin_clzll(bal);
    unsigned cabove = S - s; int dsel = 0; unsigned csel = 0u; bool found = false;
#pragma unroll
    for (int q = 15; q >= 0; --q) { if (!found) { if (cabove + h[q] >= (unsigned)need) { dsel = 16 * lane + q; csel = cabove; found = true; } else cabove += h[q]; } }
    d = __builtin_amdgcn_readlane(dsel, L); ca = (unsigned)__builtin_amdgcn_readlane((int)csel, L);
}
constexpr int CAND_CAP = 2048;
template <bool SAMPLE>
__device__ __forceinline__ void select_row(const Params& p, int row, LAS unsigned* hist, LAS unsigned* ck  , LAS unsigned short* ci  , int lane) {
    unsigned char* ws = p.ws;
    const int n = SAMPLE ? (PAST + 1 + ((row - TP) & 3)) : (row + 1);
    const int b = SAMPLE ? ((row - TP) >> 2) : 0;
    const unsigned* keys = SAMPLE ? (const unsigned*)(ws + WS_SCS) + (size_t)(row - TP) * SCS_LD : (const unsigned*)(ws + WS_SC) + (size_t)row * TP;
    const int* pt = (const int*)p.in[7] + b * 16;
    int* sel = (int*)(ws + WS_SEL) + (size_t)row * 256;
    int* cnt = (int*)(ws + WS_CNT) + row;
    if (n <= 256) {
        for (int i = 0; i < 4; ++i) { const int j = i * 64 + lane; sel[j] = sel_resolve<SAMPLE>(pt, b, j < n ? j : 0); }
        if (lane == 0) *cnt = n;
        return;
    }
    constexpr int NH = SAMPLE ? 3 : 8;
    const int nit = (n + 255) >> 8;
    const int nbatch = (nit + NH - 1) / NH;
    v4u kv[NH], nx[NH];
#pragma unroll
    for (int i = 0; i < NH; ++i) { kv[i] = (v4u){0u, 0u, 0u, 0u}; if (i < nit) kv[i] = *(const v4u*)(keys + 4 * (i * 64 + lane)); }
#pragma unroll
    for (int i = 0; i < NH; ++i) { nx[i] = (v4u){0u, 0u, 0u, 0u}; if (NH + i < nit) nx[i] = *(const v4u*)(keys + 4 * ((NH + i) * 64 + lane)); }
    unsigned L = 0u;
    if (n > 512) {
        const int ns = min((n + 1) >> 1, NH * 128);
        const float t = 256.f * (float)ns / (float)n;
        const int r = (int)(t + 4.5f * __builtin_sqrtf(t)) + 2;
#pragma unroll
        for (int q = 0; q < 4; ++q) *(LAS v4u*)(hist + 4 * (q * 64 + lane)) = (v4u){0u, 0u, 0u, 0u};
        LDS_WAIT();
#pragma unroll
        for (int i = 0; i < NH; ++i) { const int j0 = 4 * (i * 64 + lane);
            if (j0 < n) __hip_atomic_fetch_add(hist + (kv[i].x >> 22), 1u, __ATOMIC_RELAXED, __HIP_MEMORY_SCOPE_WORKGROUP);
            if (j0 + 2 < n) __hip_atomic_fetch_add(hist + (kv[i].z >> 22), 1u, __ATOMIC_RELAXED, __HIP_MEMORY_SCOPE_WORKGROUP); }
        LDS_WAIT();
        int da; unsigned caa; find_digit(hist, r, lane, da, caa);
        LDS_WAIT();
#pragma unroll
        for (int q = 0; q < 4; ++q) *(LAS v4u*)(hist + 4 * (q * 64 + lane)) = (v4u){0u, 0u, 0u, 0u};
        LDS_WAIT();
#pragma unroll
        for (int i = 0; i < NH; ++i) { const int j0 = 4 * (i * 64 + lane);
            if (j0 < n && (int)(kv[i].x >> 22) == da) __hip_atomic_fetch_add(hist + ((kv[i].x >> 12) & 1023u), 1u, __ATOMIC_RELAXED, __HIP_MEMORY_SCOPE_WORKGROUP);
            if (j0 + 2 < n && (int)(kv[i].z >> 22) == da) __hip_atomic_fetch_add(hist + ((kv[i].z >> 12) & 1023u), 1u, __ATOMIC_RELAXED, __HIP_MEMORY_SCOPE_WORKGROUP); }
        LDS_WAIT();
        int db; unsigned cab; find_digit(hist, r - (int)caa, lane, db, cab);
        L = ((unsigned)da << 22) | ((unsigned)db << 12);
        LDS_WAIT();
    }
    if (L == 0u) L = 1u;
    int m = 0;
#pragma unroll 1
    for (int hb = 0; hb < nbatch; ++hb) {
        if (256 * (hb * NH + NH) > n) {
#pragma unroll
            for (int i = 0; i < NH; ++i) { const int j0 = 4 * ((hb * NH + i) * 64 + lane);
#pragma unroll
                for (int c = 0; c < 4; ++c) kv[i][c] = (j0 + c < n) ? kv[i][c] : 0u; }
        }
#pragma unroll
        for (int i = 0; i < NH; ++i) { const int j0 = 4 * ((hb * NH + i) * 64 + lane); const v4u v = kv[i];
            bool e[4]; unsigned long long me[4]; int be = 0;
#pragma unroll
            for (int c = 0; c < 4; ++c) { e[c] = v[c] >= L; me[c] = __ballot(e[c]); be += pfx(me[c]); }
            unsigned oe = (unsigned)(m + be);
#pragma unroll
            for (int c = 0; c < 4; ++c) { const unsigned slot = min(e[c] ? oe : 0x7fffffffu, (unsigned)(CAND_CAP + lane));
                ck[slot] = v[c]; ci[slot] = (unsigned short)(j0 + c); oe += e[c] ? 1u : 0u; m += __popcll(me[c]); }
        }
#pragma unroll
        for (int i = 0; i < NH; ++i) kv[i] = nx[i];
        if (hb + 2 < nbatch) {
#pragma unroll
            for (int i = 0; i < NH; ++i) { nx[i] = (v4u){0u, 0u, 0u, 0u}; if ((hb + 2) * NH + i < nit) nx[i] = *(const v4u*)(keys + 4 * (((hb + 2) * NH + i) * 64 + lane)); }
        }
    }
    if (m < 256 || m > CAND_CAP) { select_row_slow<SAMPLE>(p, row, hist, lane); return; }
    LDS_WAIT();
    unsigned prefix = 0u, pmask = 0u; int need = 256;
    const int mq = (m + 63) >> 6;
#pragma unroll
    for (int level = 0; level < 4; ++level) {
        const int shift = level == 0 ? 22 : (level == 1 ? 12 : (level == 2 ? 2 : 0));
        const unsigned dm = level < 3 ? 1023u : 3u;
#pragma unroll
        for (int q = 0; q < 4; ++q) *(LAS v4u*)(hist + 4 * (q * 64 + lane)) = (v4u){0u, 0u, 0u, 0u};
        LDS_WAIT();
        for (int q = 0; q < mq; ++q) { const int e_ = q * 64 + lane;
            if (e_ < m) { const unsigned k = ck[e_]; if ((k & pmask) == prefix) __hip_atomic_fetch_add(hist + ((k >> shift) & dm), 1u, __ATOMIC_RELAXED, __HIP_MEMORY_SCOPE_WORKGROUP); } }
        LDS_WAIT();
        int d; unsigned ca; find_digit(hist, need, lane, d, ca);
        need -= (int)ca; prefix |= ((unsigned)d) << shift; pmask |= dm << shift;
        LDS_WAIT();
    }
    const unsigned T = prefix;
    int pos = 0, eqtaken = 0;
    for (int q = 0; q < mq; ++q) { const int e_ = q * 64 + lane; const bool valid = e_ < m;
        const unsigned k = valid ? ck[e_] : 0u;
        const bool gt = valid && k > T, eq = valid && k == T;
        const unsigned long long me = __ballot(eq);
        const bool esel = eq && (eqtaken + pfx(me) < need);
        const bool s_ = gt || esel;
        const unsigned long long ms = __ballot(s_);
        if (s_) sel[pos + pfx(ms)] = sel_resolve<SAMPLE>(pt, b, (int)ci[e_]);
        pos += __popcll(ms); eqtaken += __popcll(me); }
    if (lane == 0) *cnt = 256;
    LDS_WAIT();
}

__device__ __forceinline__ unsigned vt_off(unsigned row, unsigned ch) { return 256u * row + 16u * (ch ^ (((row & 3) << 2) | ((row >> 2) & 3))); }
template <bool SAMPLE>
__device__ __forceinline__ void attn_job(const Params& p, int row, int g, LAS unsigned char* vt, int lane) {
    unsigned char* ws = p.ws;
    LAS int* sel = (LAS int*)(vt + 8192);
    *(LAS v4u*)(sel + 4 * lane) = *(const v4u*)((const int*)(ws + WS_SEL) + (size_t)row * 256 + 4 * lane);
    const int cnt = ((const int*)(ws + WS_CNT))[row];
    LDS_WAIT();
    const int hd = lane & 15, kq = lane >> 4;
    const bf16* kbp = (const bf16*)(ws + WS_KB); const bf16* vbp = (const bf16*)(ws + WS_VB);
    const float* ck = p.in[2]; const float* cv = p.in[3]; const float* nk = p.out + O_KS; const float* nv = p.out + O_VS;
    bf16x8 qf[4];
#pragma unroll
    for (int kk = 0; kk < 4; ++kk) {
        qf[kk] = (bf16x8){0, 0, 0, 0, 0, 0, 0, 0};
        if (hd < 4) qf[kk] = *(const bf16x8*)((const bf16*)(ws + WS_QB) + (size_t)row * DM + (4 * g + hd) * 128 + 32 * kk + 8 * kq);
    }
    const float sl2 = 0.08838834764831845f * 1.4426950408889634f;
    float m_run = -1e30f, l_run = 0.f;
    f32x4 o[8];
#pragma unroll
    for (int c = 0; c < 8; ++c) o[c] = (f32x4){0.f, 0.f, 0.f, 0.f};
    for (int ch = 0; ch < 8; ++ch) {
        if (32 * ch >= cnt) break;
        const int ea = sel[32 * ch + hd], eb = sel[32 * ch + 16 + hd];
        bf16x8 ka[4], kb[4];
        if (!SAMPLE) {
            const bf16* pa = kbp + (size_t)ea * 512 + g * 128 + 8 * kq; const bf16* pb = kbp + (size_t)eb * 512 + g * 128 + 8 * kq;
#pragma unroll
            for (int kk = 0; kk < 4; ++kk) { ka[kk] = *(const bf16x8*)(pa + 32 * kk); kb[kk] = *(const bf16x8*)(pb + 32 * kk); }
        } else {
            const float* pa = ((ea & 0x40000000) ? nk + (size_t)(ea & 0xffff) * 512 : ck + (size_t)ea * 512) + g * 128 + 8 * kq;
            const float* pb = ((eb & 0x40000000) ? nk + (size_t)(eb & 0xffff) * 512 : ck + (size_t)eb * 512) + g * 128 + 8 * kq;
#pragma unroll
            for (int kk = 0; kk < 4; ++kk) {
                const f32x4 a0 = *(const f32x4*)(pa + 32 * kk), a1 = *(const f32x4*)(pa + 32 * kk + 4), b0 = *(const f32x4*)(pb + 32 * kk), b1 = *(const f32x4*)(pb + 32 * kk + 4);
                v4u wa, wb; wa.x = pk2(a0[0], a0[1]); wa.y = pk2(a0[2], a0[3]); wa.z = pk2(a1[0], a1[1]); wa.w = pk2(a1[2], a1[3]);
                wb.x = pk2(b0[0], b0[1]); wb.y = pk2(b0[2], b0[3]); wb.z = pk2(b1[0], b1[1]); wb.w = pk2(b1[2], b1[3]);
                ka[kk] = __builtin_bit_cast(bf16x8, wa); kb[kk] = __builtin_bit_cast(bf16x8, wb); }
        }
        {
            const int c16 = lane & 15, rs = lane >> 4;
#pragma unroll
            for (int i = 0; i < 8; ++i) { const int slot = rs + 4 * i; const int e = sel[32 * ch + slot];
                v4u w;
                if (!SAMPLE) w = *(const v4u*)(vbp + (size_t)e * 512 + g * 128 + 8 * c16);
                else { const float* pv = ((e & 0x40000000) ? nv + (size_t)(e & 0xffff) * 512 : cv + (size_t)e * 512) + g * 128 + 8 * c16;
                    const f32x4 a0 = *(const f32x4*)pv, a1 = *(const f32x4*)(pv + 4); w.x = pk2(a0[0], a0[1]); w.y = pk2(a0[2], a0[3]); w.z = pk2(a1[0], a1[1]); w.w = pk2(a1[2], a1[3]); }
                *(LAS v4u*)(vt + vt_off(slot, c16)) = w; }
        }
        f32x4 sa = (f32x4){0.f, 0.f, 0.f, 0.f}, sb = (f32x4){0.f, 0.f, 0.f, 0.f};
#pragma unroll
        for (int kk = 0; kk < 4; ++kk) { sa = MFMA16(ka[kk], qf[kk], sa); sb = MFMA16(kb[kk], qf[kk], sb); }
        float mx = -1e30f;
#pragma unroll
        for (int i = 0; i < 4; ++i) {
            sa[i] = (32 * ch + 4 * kq + i < cnt) ? sa[i] * sl2 : -1e30f; sb[i] = (32 * ch + 16 + 4 * kq + i < cnt) ? sb[i] * sl2 : -1e30f;
            mx = fmaxf(mx, fmaxf(sa[i], sb[i])); }
        mx = fmaxf(mx, __shfl_xor(mx, 16)); mx = fmaxf(mx, __shfl_xor(mx, 32));
        const float m_new = fmaxf(m_run, mx), alpha = exp2f(m_run - m_new);
        float ps = 0.f; float pa_[4], pb_[4];
#pragma unroll
        for (int i = 0; i < 4; ++i) { pa_[i] = exp2f(sa[i] - m_new); pb_[i] = exp2f(sb[i] - m_new); ps += pa_[i] + pb_[i]; }
        ps += __shfl_xor(ps, 16); ps += __shfl_xor(ps, 32);
        l_run = l_run * alpha + ps; m_run = m_new;
        v4u pw; pw.x = pk2(pa_[0], pa_[1]); pw.y = pk2(pa_[2], pa_[3]); pw.z = pk2(pb_[0], pb_[1]); pw.w = pk2(pb_[2], pb_[3]);
        const bf16x8 pf = __builtin_bit_cast(bf16x8, pw);
        const float al0 = __int_as_float(__builtin_amdgcn_readlane(__float_as_int(alpha), 0)), al1 = __int_as_float(__builtin_amdgcn_readlane(__float_as_int(alpha), 1)), al2 = __int_as_float(__builtin_amdgcn_readlane(__float_as_int(alpha), 2)), al3 = __int_as_float(__builtin_amdgcn_readlane(__float_as_int(alpha), 3));
#pragma unroll
        for (int c = 0; c < 8; ++c) { o[c][0] *= al0; o[c][1] *= al1; o[c][2] *= al2; o[c][3] *= al3; }
        LDS_WAIT();
        const unsigned q4 = (unsigned)(hd >> 2), p4 = (unsigned)(lane & 3);
#pragma unroll
        for (int c = 0; c < 8; ++c) {
            const unsigned r0 = 4u * kq + q4, r1 = 16u + 4u * kq + q4, chk = 2u * c + (p4 >> 1);
            const v4i16_t lo = __builtin_amdgcn_ds_read_tr16_b64_v4i16((LAS v4i16_t*)(vt + vt_off(r0, chk) + 8u * (p4 & 1u)));
            const v4i16_t hi = __builtin_amdgcn_ds_read_tr16_b64_v4i16((LAS v4i16_t*)(vt + vt_off(r1, chk) + 8u * (p4 & 1u)));
            const bf16x8 vf = (bf16x8){lo[0], lo[1], lo[2], lo[3], hi[0], hi[1], hi[2], hi[3]};
            o[c] = MFMA16(pf, vf, o[c]);
        }
        LDS_WAIT();
    }
    const float l0 = __int_as_float(__builtin_amdgcn_readlane(__float_as_int(l_run), 0)), l1 = __int_as_float(__builtin_amdgcn_readlane(__float_as_int(l_run), 1)), l2 = __int_as_float(__builtin_amdgcn_readlane(__float_as_int(l_run), 2)), l3 = __int_as_float(__builtin_amdgcn_readlane(__float_as_int(l_run), 3));
    if (lane < 16) {
        bf16* ao = (bf16*)(ws + WS_AO) + (size_t)row * DM + (4 * g) * 128 + lane;
        const float i0 = 1.f / l0, i1 = 1.f / l1, i2 = 1.f / l2, i3 = 1.f / l3;
#pragma unroll
        for (int c = 0; c < 8; ++c) {
            ao[0 * 128 + 16 * c] = (bf16)(pk2(o[c][0] * i0, 0.f) & 0xffffu); ao[1 * 128 + 16 * c] = (bf16)(pk2(o[c][1] * i1, 0.f) & 0xffffu);
            ao[2 * 128 + 16 * c] = (bf16)(pk2(o[c][2] * i2, 0.f) & 0xffffu); ao[3 * 128 + 16 * c] = (bf16)(pk2(o[c][3] * i3, 0.f) & 0xffffu); }
    }
}

__device__ __forceinline__ bf16x8 fp8x8_to_bf16(unsigned w0, unsigned w1) {
    const f32x2 a = __builtin_amdgcn_cvt_pk_f32_fp8((int)w0, false), b = __builtin_amdgcn_cvt_pk_f32_fp8((int)w0, true);
    const f32x2 c = __builtin_amdgcn_cvt_pk_f32_fp8((int)w1, false), d = __builtin_amdgcn_cvt_pk_f32_fp8((int)w1, true);
    v4u o;
    o.x = __builtin_amdgcn_perm(__float_as_uint(a[1]), __float_as_uint(a[0]), 0x07060302u); o.y = __builtin_amdgcn_perm(__float_as_uint(b[1]), __float_as_uint(b[0]), 0x07060302u);
    o.z = __builtin_amdgcn_perm(__float_as_uint(c[1]), __float_as_uint(c[0]), 0x07060302u); o.w = __builtin_amdgcn_perm(__float_as_uint(d[1]), __float_as_uint(d[0]), 0x07060302u);
    return __builtin_bit_cast(bf16x8, o);
}
struct AttnPf { v4u k[4]; v4u v[4]; };
__device__ __forceinline__ void attn_prefetch(AttnPf& f, const unsigned char* k8, const unsigned char* v8, const LAS int* selb, int ch, int g, int lane) {
    const int hd = lane & 15, kq = lane >> 4;
    const int ea = selb[32 * ch + hd], eb = selb[32 * ch + 16 + hd];
    const unsigned char* pa = k8 + (size_t)ea * 512 + g * 128 + 32 * kq; const unsigned char* pb = k8 + (size_t)eb * 512 + g * 128 + 32 * kq;
    f.k[0] = *(const v4u*)pa; f.k[1] = *(const v4u*)(pa + 16); f.k[2] = *(const v4u*)pb; f.k[3] = *(const v4u*)(pb + 16);
#pragma unroll
    for (int i = 0; i < 4; ++i) { const int e = selb[32 * ch + (lane >> 3) + 8 * i]; f.v[i] = *(const v4u*)(v8 + (size_t)e * 512 + g * 128 + 16 * (lane & 7)); }
}
#define MFMA16F8(a, b, c) __builtin_amdgcn_mfma_f32_16x16x32_fp8_fp8((a), (b), (c), 0, 0, 0)
__device__ __forceinline__ long pk64(unsigned lo, unsigned hi) { return (long)(((unsigned long long)hi << 32) | (unsigned long long)lo); }
template <bool ONLINE>
__device__ __forceinline__ void attn_chunk(const AttnPf& f, const long (&qf)[4], int ch, int cnt, float mb, float& m_run, float& l_run, f32x4 (&o)[8], LAS unsigned char* vt, int lane) {
    const int hd = lane & 15, kq = lane >> 4;
    const float sl2 = 0.08838834764831845f * 1.4426950408889634f;
#pragma unroll
    for (int i = 0; i < 4; ++i) { const unsigned slot = (unsigned)((lane >> 3) + 8 * i), c8 = (unsigned)(lane & 7);
        *(LAS bf16x8*)(vt + vt_off(slot, 2 * c8)) = fp8x8_to_bf16(f.v[i].x, f.v[i].y); *(LAS bf16x8*)(vt + vt_off(slot, 2 * c8 + 1)) = fp8x8_to_bf16(f.v[i].z, f.v[i].w); }
    f32x4 sa = (f32x4){0.f, 0.f, 0.f, 0.f}, sb = (f32x4){0.f, 0.f, 0.f, 0.f};
    sa = MFMA16F8(pk64(f.k[0].x, f.k[0].y), qf[0], sa); sa = MFMA16F8(pk64(f.k[0].z, f.k[0].w), qf[1], sa);
    sa = MFMA16F8(pk64(f.k[1].x, f.k[1].y), qf[2], sa); sa = MFMA16F8(pk64(f.k[1].z, f.k[1].w), qf[3], sa);
    sb = MFMA16F8(pk64(f.k[2].x, f.k[2].y), qf[0], sb); sb = MFMA16F8(pk64(f.k[2].z, f.k[2].w), qf[1], sb);
    sb = MFMA16F8(pk64(f.k[3].x, f.k[3].y), qf[2], sb); sb = MFMA16F8(pk64(f.k[3].z, f.k[3].w), qf[3], sb);
    float pa_[4], pb_[4];
    if (ONLINE) {
        float mx = -1e30f;
#pragma unroll
        for (int i = 0; i < 4; ++i) {
            sa[i] = (32 * ch + 4 * kq + i < cnt) ? sa[i] * sl2 : -1e30f; sb[i] = (32 * ch + 16 + 4 * kq + i < cnt) ? sb[i] * sl2 : -1e30f;
            mx = fmaxf(mx, fmaxf(sa[i], sb[i])); }
        mx = fmaxf(mx, __shfl_xor(mx, 16)); mx = fmaxf(mx, __shfl_xor(mx, 32));
        const float m_new = fmaxf(m_run, mx), alpha = exp2f(m_run - m_new);
        float ps = 0.f;
#pragma unroll
        for (int i = 0; i < 4; ++i) { pa_[i] = exp2f(sa[i] - m_new); pb_[i] = exp2f(sb[i] - m_new); ps += pa_[i] + pb_[i]; }
        ps += __shfl_xor(ps, 16); ps += __shfl_xor(ps, 32);
        l_run = l_run * alpha + ps; m_run = m_new;
        const float al0 = __int_as_float(__builtin_amdgcn_readlane(__float_as_int(alpha), 0)), al1 = __int_as_float(__builtin_amdgcn_readlane(__float_as_int(alpha), 1)), al2 = __int_as_float(__builtin_amdgcn_readlane(__float_as_int(alpha), 2)), al3 = __int_as_float(__builtin_amdgcn_readlane(__float_as_int(alpha), 3));
#pragma unroll
        for (int c = 0; c < 8; ++c) { o[c][0] *= al0; o[c][1] *= al1; o[c][2] *= al2; o[c][3] *= al3; }
    } else {
        float ps = 0.f;
#pragma unroll
        for (int i = 0; i < 4; ++i) {
            pa_[i] = (32 * ch + 4 * kq + i < cnt) ? __builtin_amdgcn_exp2f(sa[i] * sl2 - mb) : 0.f; pb_[i] = (32 * ch + 16 + 4 * kq + i < cnt) ? __builtin_amdgcn_exp2f(sb[i] * sl2 - mb) : 0.f;
            ps += pa_[i] + pb_[i]; }
        l_run += ps;
    }
    v4u pw; pw.x = pk2(pa_[0], pa_[1]); pw.y = pk2(pa_[2], pa_[3]); pw.z = pk2(pb_[0], pb_[1]); pw.w = pk2(pb_[2], pb_[3]);
    const bf16x8 pf = __builtin_bit_cast(bf16x8, pw);
    LDS_WAIT();
    const unsigned q4 = (unsigned)(hd >> 2), p4 = (unsigned)(lane & 3);
#pragma unroll
    for (int c = 0; c < 8; ++c) {
        const unsigned r0 = 4u * kq + q4, r1 = 16u + 4u * kq + q4, chk = 2u * c + (p4 >> 1);
        const v4i16_t lo = __builtin_amdgcn_ds_read_tr16_b64_v4i16((LAS v4i16_t*)(vt + vt_off(r0, chk) + 8u * (p4 & 1u)));
        const v4i16_t hi = __builtin_amdgcn_ds_read_tr16_b64_v4i16((LAS v4i16_t*)(vt + vt_off(r1, chk) + 8u * (p4 & 1u)));
        const bf16x8 vf = (bf16x8){lo[0], lo[1], lo[2], lo[3], hi[0], hi[1], hi[2], hi[3]};
        o[c] = MFMA16(pf, vf, o[c]);
    }
}
template <bool ONLINE>
__device__ __forceinline__ void attn_job_prompt(const Params& p, int row, int g, float mb, LAS unsigned char* vt, LAS int* selb, int lane, int cnt, v4u selv, int nrow, int& ncnt, v4u& nselv) {
    unsigned char* ws = p.ws;
    const int nch = (cnt + 31) >> 5;
    const int hd = lane & 15, kq = lane >> 4;
    *(LAS v4u*)(selb + 4 * lane) = selv;
    if (nrow >= 0) { ncnt = ((const int*)(ws + WS_CNT))[nrow]; nselv = *(const v4u*)((const int*)(ws + WS_SEL) + (size_t)nrow * 256 + 4 * lane); }
    long qf[4];
#pragma unroll
    for (int kk = 0; kk < 4; ++kk) {
        qf[kk] = 0;
        if (hd < 4) { const v4u w = *(const v4u*)((const bf16*)(ws + WS_QB) + (size_t)row * DM + (4 * g + hd) * 128 + 32 * kq + 8 * kk);
            int lo = __builtin_amdgcn_cvt_pk_fp8_f32(bf_lo(w.x), bf_hi(w.x), 0, false); lo = __builtin_amdgcn_cvt_pk_fp8_f32(bf_lo(w.y), bf_hi(w.y), lo, true);
            int hi = __builtin_amdgcn_cvt_pk_fp8_f32(bf_lo(w.z), bf_hi(w.z), 0, false); hi = __builtin_amdgcn_cvt_pk_fp8_f32(bf_lo(w.w), bf_hi(w.w), hi, true);
            qf[kk] = pk64((unsigned)lo, (unsigned)hi); }
    }
    LDS_WAIT();
    const unsigned char* k8 = ws + WS_K8; const unsigned char* v8 = ws + WS_V8;
    float m_run = -1e30f, l_run = 0.f;
    f32x4 o[8];
#pragma unroll
    for (int c = 0; c < 8; ++c) o[c] = (f32x4){0.f, 0.f, 0.f, 0.f};
    AttnPf f0, f1, f2;
    attn_prefetch(f0, k8, v8, selb, 0, g, lane);
    if (nch > 1) attn_prefetch(f1, k8, v8, selb, 1, g, lane);
    if (nch > 2) attn_prefetch(f2, k8, v8, selb, 2, g, lane);
    for (int ch = 0; ch < nch; ch += 3) {
        attn_chunk<ONLINE>(f0, qf, ch, cnt, mb, m_run, l_run, o, vt, lane);
        if (ch + 3 < nch) attn_prefetch(f0, k8, v8, selb, ch + 3, g, lane);
        if (ch + 1 < nch) {
            attn_chunk<ONLINE>(f1, qf, ch + 1, cnt, mb, m_run, l_run, o, vt, lane);
            if (ch + 4 < nch) attn_prefetch(f1, k8, v8, selb, ch + 4, g, lane);
        }
        if (ch + 2 < nch) {
            attn_chunk<ONLINE>(f2, qf, ch + 2, cnt, mb, m_run, l_run, o, vt, lane);
            if (ch + 5 < nch) attn_prefetch(f2, k8, v8, selb, ch + 5, g, lane);
        }
    }
    if (!ONLINE) { l_run += __shfl_xor(l_run, 16); l_run += __shfl_xor(l_run, 32); }
    const float l0 = __int_as_float(__builtin_amdgcn_readlane(__float_as_int(l_run), 0)), l1 = __int_as_float(__builtin_amdgcn_readlane(__float_as_int(l_run), 1)), l2 = __int_as_float(__builtin_amdgcn_readlane(__float_as_int(l_run), 2)), l3 = __int_as_float(__builtin_amdgcn_readlane(__float_as_int(l_run), 3));
    if (lane < 16) {
        bf16* ao = (bf16*)(ws + WS_AO) + (size_t)row * DM + (4 * g) * 128 + lane;
        const float i0 = 1.f / l0, i1 = 1.f / l1, i2 = 1.f / l2, i3 = 1.f / l3;
#pragma unroll
        for (int c = 0; c < 8; ++c) {
            ao[0 * 128 + 16 * c] = (bf16)(pk2(o[c][0] * i0, 0.f) & 0xffffu); ao[1 * 128 + 16 * c] = (bf16)(pk2(o[c][1] * i1, 0.f) & 0xffffu);
            ao[2 * 128 + 16 * c] = (bf16)(pk2(o[c][2] * i2, 0.f) & 0xffffu); ao[3 * 128 + 16 * c] = (bf16)(pk2(o[c][3] * i3, 0.f) & 0xffffu); }
    }
    LDS_WAIT();
}
template <bool ONLINE, bool GROUPED>
__device__ __forceinline__ void attn_prompt_loop(const Params& p, int j0, int stride, int njobs, int gfix, float mb, LAS unsigned char* vt, LAS int* selb, int lane) {
    unsigned char* ws = p.ws;
    if (j0 >= njobs) return;
    int row = GROUPED ? TP - 1 - j0 : TP - 1 - (j0 >> 2);
    int cnt = ((const int*)(ws + WS_CNT))[row]; v4u selv = *(const v4u*)((const int*)(ws + WS_SEL) + (size_t)row * 256 + 4 * lane);
    for (int j = j0; j < njobs; j += stride) {
        const int jn = j + stride;
        const int nrow = jn < njobs ? (GROUPED ? TP - 1 - jn : TP - 1 - (jn >> 2)) : -1;
        int ncnt = 0; v4u nselv = (v4u){0u, 0u, 0u, 0u};
        attn_job_prompt<ONLINE>(p, row, GROUPED ? gfix : (j & 3), mb, vt, selb, lane, cnt, selv, nrow, ncnt, nselv);
        row = nrow; cnt = ncnt; selv = nselv;
    }
}

__device__ __forceinline__ float wave_scan_incl(float v, int lane) {
    (void)lane;
#define DPP_FM(x, ctrl, rm) __int_as_float(__builtin_amdgcn_update_dpp(0, __float_as_int(x), (ctrl), (rm), 0xf, false))
    v += DPP_FM(v, 0x111, 0xf); v += DPP_FM(v, 0x112, 0xf); v += DPP_FM(v, 0x114, 0xf); v += DPP_FM(v, 0x118, 0xf);
    v += DPP_FM(v, 0x142, 0xa); v += DPP_FM(v, 0x143, 0xc);
#undef DPP_FM
    return v;
}
__device__ __forceinline__ bf16x8 scale_frag2(bf16x8 x, const LAS float* fl, const LAS float* fh) {
    const v4u w = __builtin_bit_cast(v4u, x); const f32x4 f0 = *(const LAS f32x4*)fl, f1 = *(const LAS f32x4*)fh;
    v4u o; o.x = pk2(bf_lo(w.x) * f0[0], bf_hi(w.x) * f0[1]); o.y = pk2(bf_lo(w.y) * f0[2], bf_hi(w.y) * f0[3]);
    o.z = pk2(bf_lo(w.z) * f1[0], bf_hi(w.z) * f1[1]); o.w = pk2(bf_lo(w.w) * f1[2], bf_hi(w.w) * f1[3]);
    return __builtin_bit_cast(bf16x8, o);
}
__device__ __forceinline__ bf16x8 scale_frag(bf16x8 x, const LAS float* f) {
    const v4u w = __builtin_bit_cast(v4u, x); const f32x4 f0 = *(const LAS f32x4*)f, f1 = *(const LAS f32x4*)(f + 4);
    v4u o; o.x = pk2(bf_lo(w.x) * f0[0], bf_hi(w.x) * f0[1]); o.y = pk2(bf_lo(w.y) * f0[2], bf_hi(w.y) * f0[3]);
    o.z = pk2(bf_lo(w.z) * f1[0], bf_hi(w.z) * f1[1]); o.w = pk2(bf_lo(w.w) * f1[2], bf_hi(w.w) * f1[3]);
    return __builtin_bit_cast(bf16x8, o);
}
__device__ __forceinline__ void ssd_chunk_state(const Params& p, int c, int h, LAS float* fa, int lane) {
    unsigned char* ws = p.ws;
    const int g = h >> 3, t0 = 128 * c, r = lane & 31, hh = lane >> 5;
    const float* dtb = (const float*)(ws + WS_DTB);
    const float a = -expf(p.in[17][h]);
    const float d0 = dtb[(size_t)(t0 + lane) * 64 + h], d1 = dtb[(size_t)(t0 + 64 + lane) * 64 + h];
    const float c0 = wave_scan_incl(d0 * a, lane), tot0 = __int_as_float(__builtin_amdgcn_readlane(__float_as_int(c0), 63));
    const float c1 = wave_scan_incl(d1 * a, lane) + tot0, last = __int_as_float(__builtin_amdgcn_readlane(__float_as_int(c1), 63));
    fa[lane] = d0 * __expf(last - c0); fa[64 + lane] = d1 * __expf(last - c1);
    if (lane == 0) ((float*)(ws + WS_CSL))[c * 64 + h] = last;
    LDS_WAIT();
    f32x16 acc[2][4];
#pragma unroll
    for (int a_ = 0; a_ < 2; ++a_)
#pragma unroll
        for (int b_ = 0; b_ < 4; ++b_)
#pragma unroll
            for (int i = 0; i < 16; ++i) acc[a_][b_][i] = 0.f;
    const bf16* xt = (const bf16*)(ws + WS_XT) + (size_t)(c * 64 + h) * 8192 + lane * 8;
    const bf16* bt = (const bf16*)(ws + WS_BT) + (size_t)(c * 8 + g) * 16384 + lane * 8;
    bf16x8 xr[2], br[4];
#pragma unroll
    for (int pt = 0; pt < 2; ++pt) xr[pt] = *(const bf16x8*)(xt + (pt * 8) * 512);
#pragma unroll
    for (int ct = 0; ct < 4; ++ct) br[ct] = *(const bf16x8*)(bt + (ct * 8) * 512);
#pragma unroll 1
    for (int ks = 0; ks < 8; ++ks) {
        bf16x8 af[2], bf_[4];
#pragma unroll
        for (int pt = 0; pt < 2; ++pt) af[pt] = scale_frag2(xr[pt], fa + 16 * ks + 4 * hh, fa + 16 * ks + 8 + 4 * hh);
#pragma unroll
        for (int ct = 0; ct < 4; ++ct) bf_[ct] = br[ct];
        const int kn = ks < 7 ? ks + 1 : 7;
#pragma unroll
        for (int pt = 0; pt < 2; ++pt) xr[pt] = *(const bf16x8*)(xt + (pt * 8 + kn) * 512);
#pragma unroll
        for (int ct = 0; ct < 4; ++ct) br[ct] = *(const bf16x8*)(bt + (ct * 8 + kn) * 512);
#pragma unroll
        for (int pt = 0; pt < 2; ++pt)
#pragma unroll
            for (int ct = 0; ct < 4; ++ct) acc[pt][ct] = MFMA32(af[pt], bf_[ct], acc[pt][ct]);
    }
    unsigned* cs = (unsigned*)(ws + WS_CS) + (size_t)(c * 64 + h) * 32 * 128;
#pragma unroll
    for (int pt = 0; pt < 2; ++pt)
#pragma unroll
        for (int ct = 0; ct < 4; ++ct)
#pragma unroll
            for (int i = 0; i < 16; i += 2) { const int pp = 32 * pt + (i & 3) + 8 * (i >> 2) + 4 * hh; cs[(size_t)(pp >> 1) * 128 + 32 * ct + r] = pk2(acc[pt][ct][i], acc[pt][ct][i + 1]); }
    LDS_WAIT();
}
__device__ __forceinline__ void ssd_state_scan(const Params& p, int gtid, int gthreads) {
    unsigned char* ws = p.ws;
    const float* csl = (const float*)(ws + WS_CSL);
    for (int e = gtid; e < 64 * 64 * 32; e += gthreads) {
        const int h = e >> 11, q = e & 2047, pp_ = (q >> 6) * 2, n_ = (q & 63) * 2;
        const v2u* cs = (const v2u*)(ws + WS_CS) + e;
        bf16* st = (bf16*)(ws + WS_STIN) + ((((size_t)h * 2 + (pp_ >> 5)) * 8 + (n_ >> 4)) * 64 + (pp_ & 31) + 32 * ((n_ >> 3) & 1)) * 8 + (n_ & 7);
        f32x4 cur = (f32x4){0.f, 0.f, 0.f, 0.f};
#pragma unroll 8
        for (int c = 0; c < 64; ++c) {
            const v2u t = cs[(size_t)c * 131072];
            *(unsigned*)(st + (size_t)c * 524288) = pk2(cur[0], cur[2]); *(unsigned*)(st + (size_t)c * 524288 + 8) = pk2(cur[1], cur[3]);
            const float dec = __expf(csl[c * 64 + h]);
            cur = cur * dec + (f32x4){bf_lo(t.x), bf_hi(t.x), bf_lo(t.y), bf_hi(t.y)};
        }
        float* o = p.out + O_SSP + ((size_t)h * 64 + pp_) * 128 + n_;
        *(f32x2*)o = (f32x2){cur[0], cur[2]}; *(f32x2*)(o + 128) = (f32x2){cur[1], cur[3]};
    }
}
__device__ __forceinline__ void ssd_output_unit(const Params& p, int c, int g, LAS float* wl  , LAS float* ex  , LAS float* ys  , int wave, int lane) {
    unsigned char* ws = p.ws;
    const int h = 8 * g + wave, t0 = 128 * c, r = lane & 31, hh = lane >> 5;
    const float* dtb = (const float*)(ws + WS_DTB);
    const float a = -expf(p.in[17][h]);
    {
        const float d0 = dtb[(size_t)(t0 + lane) * 64 + h], d1 = dtb[(size_t)(t0 + 64 + lane) * 64 + h];
        const float c0 = wave_scan_incl(d0 * a, lane), tot0 = __int_as_float(__builtin_amdgcn_readlane(__float_as_int(c0), 63));
        const float c1 = wave_scan_incl(d1 * a, lane) + tot0;
        wl[lane] = c0; wl[64 + lane] = c1; wl[128 + lane] = d0; wl[192 + lane] = d1;
        LDS_WAIT();
    }
    const bf16* crow = (const bf16*)(ws + WS_CROW) + (size_t)(c * 8 + g) * 16384 + lane * 8;
    const bf16* brow = (const bf16*)(ws + WS_BROW) + (size_t)(c * 8 + g) * 16384 + lane * 8;
    const bf16* stin = (const bf16*)(ws + WS_STIN) + (size_t)(c * 64 + h) * 8192 + lane * 8;
    const bf16* xt = (const bf16*)(ws + WS_XT) + (size_t)(c * 64 + h) * 8192 + lane * 8;
    const int erow = lane >> 1, ehalf = lane & 1;
    const bf16* zp = (const bf16*)(ws + WS_PROJ) + (size_t)(t0 + erow) * NIN + C_Z + h * 64 + 32 * ehalf;
    const float dsk = p.in[18][h];
    bf16* so = (bf16*)(ws + WS_SSMO) + (size_t)t0 * DI + h * 64;
#pragma unroll 1
    for (int li = 0; li < 4; ++li) {
        bf16x8 cf[8], nb[8]; v4u nx[2][2], zr[4];
        f32x16 Y[2];
        {
            bf16x8 sf[2][8];
#pragma unroll
            for (int kk = 0; kk < 8; ++kk) cf[kk] = *(const bf16x8*)(crow + (li * 8 + kk) * 512);
#pragma unroll
            for (int pt = 0; pt < 2; ++pt)
#pragma unroll
                for (int kk = 0; kk < 8; ++kk) sf[pt][kk] = *(const bf16x8*)(stin + (pt * 8 + kk) * 512);
#pragma unroll
            for (int pt = 0; pt < 2; ++pt)
#pragma unroll
                for (int i = 0; i < 16; ++i) Y[pt][i] = 0.f;
#pragma unroll
            for (int kk = 0; kk < 8; ++kk)
#pragma unroll
                for (int pt = 0; pt < 2; ++pt) Y[pt] = MFMA32(cf[kk], sf[pt][kk], Y[pt]);
        }
#pragma unroll
        for (int kk = 0; kk < 8; ++kk) nb[kk] = *(const bf16x8*)(brow + kk * 512);
#pragma unroll
        for (int q = 0; q < 4; ++q) zr[q] = *(const v4u*)(zp + (size_t)(32 * li) * NIN + 8 * q);
#pragma unroll
        for (int i = 0; i < 16; ++i) { const float e = __expf(wl[32 * li + (i & 3) + 8 * (i >> 2) + 4 * hh]); Y[0][i] *= e; Y[1][i] *= e; }
        const float csl_ = wl[32 * li + r];
        v4u xd[2][2];
#pragma unroll 1
        for (int si = 0; si <= li; ++si) {
#pragma unroll
            for (int st = 0; st < 2; ++st)
#pragma unroll
                for (int pt = 0; pt < 2; ++pt) nx[st][pt] = *(const v4u*)(xt + (pt * 8 + 2 * si + st) * 512);
            f32x16 X;
#pragma unroll
            for (int i = 0; i < 16; ++i) X[i] = 0.f;
#pragma unroll
            for (int kk = 0; kk < 8; ++kk) X = MFMA32(nb[kk], cf[kk], X);
            if (si < li) {
#pragma unroll
                for (int kk = 0; kk < 8; ++kk) nb[kk] = *(const bf16x8*)(brow + ((si + 1) * 8 + kk) * 512);
            }
#pragma unroll
            for (int i = 0; i < 16; ++i) { const int sl = 32 * si + (i & 3) + 8 * (i >> 2) + 4 * hh, ll = 32 * li + r;
                X[i] = (sl <= ll) ? X[i] * __expf(csl_ - wl[sl]) * wl[128 + sl] : 0.f; }
#pragma unroll
            for (int st = 0; st < 2; ++st) {
                v4u aw; aw.x = pk2(X[8 * st + 0], X[8 * st + 1]); aw.y = pk2(X[8 * st + 2], X[8 * st + 3]); aw.z = pk2(X[8 * st + 4], X[8 * st + 5]); aw.w = pk2(X[8 * st + 6], X[8 * st + 7]);
                const bf16x8 af = __builtin_bit_cast(bf16x8, aw);
#pragma unroll
                for (int pt = 0; pt < 2; ++pt) Y[pt] = MFMA32(af, __builtin_bit_cast(bf16x8, nx[st][pt]), Y[pt]);
            }
        }
#pragma unroll
        for (int st = 0; st < 2; ++st)
#pragma unroll
            for (int pt = 0; pt < 2; ++pt) xd[st][pt] = nx[st][pt];
#pragma unroll
        for (int pt = 0; pt < 2; ++pt)
#pragma unroll
            for (int q = 0; q < 4; ++q) {
                const unsigned xw0 = (q & 1) ? xd[q >> 1][pt].z : xd[q >> 1][pt].x, xw1 = (q & 1) ? xd[q >> 1][pt].w : xd[q >> 1][pt].y;
                const float xv[4] = {bf_lo(xw0), bf_hi(xw0), bf_lo(xw1), bf_hi(xw1)};
#pragma unroll
                for (int e = 0; e < 4; ++e) ys[(8 * q + 4 * hh + e) * 68 + 32 * pt + r] = Y[pt][4 * q + e] + dsk * xv[e];
            }
        LDS_WAIT();
        {
            float yv[32];
#pragma unroll
            for (int q = 0; q < 8; ++q) { const f32x4 t = *(const LAS f32x4*)(ys + erow * 68 + 32 * ehalf + 4 * q); yv[4 * q] = t[0]; yv[4 * q + 1] = t[1]; yv[4 * q + 2] = t[2]; yv[4 * q + 3] = t[3]; }
            float sq = 0.f; v4u ow[4];
#pragma unroll
            for (int q = 0; q < 4; ++q) {
                const unsigned zw[4] = {zr[q].x, zr[q].y, zr[q].z, zr[q].w}; unsigned o4[4];
#pragma unroll
                for (int j = 0; j < 4; ++j) { const float y0 = yv[8 * q + 2 * j] * siluf_(bf_lo(zw[j])), y1 = yv[8 * q + 2 * j + 1] * siluf_(bf_hi(zw[j])); sq += y0 * y0 + y1 * y1; o4[j] = pk2(y0, y1); }
                ow[q] = (v4u){o4[0], o4[1], o4[2], o4[3]};
            }
            sq = sum2(sq);
            if (ehalf == 0) ex[(32 * li + erow) * 8 + wave] = sq;
            bf16* q_ = so + (size_t)(32 * li + erow) * DI + 32 * ehalf;
#pragma unroll
            for (int q = 0; q < 4; ++q) *(v4u*)(q_ + 8 * q) = ow[q];
        }
        LDS_WAIT();
    }
    LDS_WAIT(); VM_WAIT();
    __syncthreads();
    {
        const int chn = lane & 7, rsb = lane >> 3;
        const f32x4 g0 = *(const f32x4*)(p.in[19] + h * 64 + 8 * chn), g1 = *(const f32x4*)(p.in[19] + h * 64 + 8 * chn + 4);
#pragma unroll 4
        for (int k = 0; k < 16; ++k) { const int l = rsb + 8 * k;
            const LAS f32x4* e4 = (const LAS f32x4*)(ex + l * 8); const f32x4 ea = e4[0], eb = e4[1];
            const float tot = ((ea[0] + ea[1]) + (ea[2] + ea[3])) + ((eb[0] + eb[1]) + (eb[2] + eb[3]));
            const float rs = rsqrtf(tot * (1.f / 512.f) + EPS);
            bf16* q = so + (size_t)l * DI + 8 * chn; const v4u w = *(const v4u*)q;
            v4u o; o.x = pk2(bf_lo(w.x) * rs * g0[0], bf_hi(w.x) * rs * g0[1]); o.y = pk2(bf_lo(w.y) * rs * g0[2], bf_hi(w.y) * rs * g0[3]);
            o.z = pk2(bf_lo(w.z) * rs * g1[0], bf_hi(w.z) * rs * g1[1]); o.w = pk2(bf_lo(w.w) * rs * g1[2], bf_hi(w.w) * rs * g1[3]);
            *(v4u*)q = o; }
    }
    __syncthreads();
}
__device__ __forceinline__ void ssd_sample_unit(const Params& p, int b, int g, LAS float* ex  , LAS bf16* xzl  , int wave, int lane) {
    unsigned char* ws = p.ws;
    const int h = 8 * g + wave, r0 = TP + 4 * b, pq = lane >> 4, nq = lane & 15;
    const float* dtb = (const float*)(ws + WS_DTB);
    const float a = -expf(p.in[17][h]);
    float dt[4], cs[4];
#pragma unroll
    for (int s = 0; s < 4; ++s) { dt[s] = dtb[(size_t)(r0 + s) * 64 + h]; cs[s] = dt[s] * a + (s ? cs[s - 1] : 0.f); }
    const bf16* xbs = (const bf16*)(ws + WS_XBS) + (size_t)(4 * b) * CONVD;
    {
        const int tid = wave * 64 + lane, row = tid >> 7, chn = (tid & 127) * 4;
        const v2u xv = *(const v2u*)(xbs + (size_t)row * CONVD + g * 512 + chn);
        const v2u zv = *(const v2u*)((const bf16*)(ws + WS_PROJ) + (size_t)(r0 + row) * NIN + C_Z + g * 512 + chn);
        *(LAS v2u*)(xzl + row * 512 + chn) = xv; *(LAS v2u*)(xzl + 2048 + row * 512 + chn) = zv;
    }
    float Bn[4][8], Cn[4][8];
#pragma unroll
    for (int s = 0; s < 4; ++s) {
        const bf16* bp = xbs + (size_t)s * CONVD + DI + g * 128 + 8 * nq; const bf16* cp = bp + 1024;
        const v4u b0 = *(const v4u*)bp, c0 = *(const v4u*)cp;
        const unsigned bw[4] = {b0.x, b0.y, b0.z, b0.w}, cw[4] = {c0.x, c0.y, c0.z, c0.w};
#pragma unroll
        for (int j = 0; j < 4; ++j) { Bn[s][2 * j] = bf_lo(bw[j]); Bn[s][2 * j + 1] = bf_hi(bw[j]); Cn[s][2 * j] = bf_lo(cw[j]); Cn[s][2 * j + 1] = bf_hi(cw[j]); }
    }
    float cbm[4][4];
#pragma unroll
    for (int l = 0; l < 4; ++l)
#pragma unroll
        for (int s = 0; s < 4; ++s) { float v = 0.f;
            if (s <= l) {
#pragma unroll
                for (int j = 0; j < 8; ++j) v += Cn[l][j] * Bn[s][j];
                v = sum16(v);
                v *= __expf(cs[l] - cs[s]) * dt[s]; }
            cbm[l][s] = v; }
    float ecs[4], fdec[4];
#pragma unroll
    for (int s = 0; s < 4; ++s) { ecs[s] = __expf(cs[s]); fdec[s] = dt[s] * __expf(cs[3] - cs[s]); }
    const float e3 = ecs[3], dsk = p.in[18][h];
    const float* sin_ = p.in[6] + ((size_t)(b * 64 + h) * 64) * 128 + 8 * nq;
    float* sout = p.out + O_SSS + ((size_t)(b * 64 + h) * 64) * 128 + 8 * nq;
    const bf16* zp = (const bf16*)(ws + WS_PROJ) + (size_t)r0 * NIN + C_Z + h * 64;
    float sq[4] = {0.f, 0.f, 0.f, 0.f};
    bf16* so = (bf16*)(ws + WS_SSMO) + (size_t)r0 * DI + h * 64;
    f32x4 S[4][2];
#pragma unroll
    for (int u = 0; u < 4; ++u)
#pragma unroll
        for (int q = 0; q < 2; ++q) S[u][q] = *(const f32x4*)(sin_ + (size_t)(pq + 4 * u) * 128 + 4 * q);
    LDS_WAIT();
    __syncthreads();
#pragma unroll 1
    for (int i0 = 0; i0 < 16; i0 += 4) {
        f32x4 Sn[4][2];
        const int inx = (i0 + 4 < 16) ? i0 + 4 : i0;
#pragma unroll
        for (int u = 0; u < 4; ++u)
#pragma unroll
            for (int q = 0; q < 2; ++q) Sn[u][q] = *(const f32x4*)(sin_ + (size_t)(pq + 4 * (inx + u)) * 128 + 4 * q);
#pragma unroll
        for (int u = 0; u < 4; ++u) {
            const int pp = pq + 4 * (i0 + u);
            float xs[4], xd[4];
#pragma unroll
            for (int s = 0; s < 4; ++s) { xs[s] = bf1(xzl[s * 512 + wave * 64 + pp]); xd[s] = xs[s] * fdec[s]; }
            float yo[4] = {0.f, 0.f, 0.f, 0.f};
#pragma unroll
            for (int q = 0; q < 2; ++q)
#pragma unroll
                for (int e = 0; e < 4; ++e) { const float sv = S[u][q][e]; const int j = 4 * q + e;
#pragma unroll
                    for (int l = 0; l < 4; ++l) yo[l] += Cn[l][j] * sv;
                    S[u][q][e] = e3 * sv + ((Bn[0][j] * xd[0] + Bn[1][j] * xd[1]) + (Bn[2][j] * xd[2] + Bn[3][j] * xd[3])); }
#pragma unroll
            for (int q = 0; q < 2; ++q) *(f32x4*)(sout + (size_t)pp * 128 + 4 * q) = S[u][q];
#pragma unroll
            for (int l = 0; l < 4; ++l) { float v = yo[l]; v = sum16(v);
                float yd = 0.f;
#pragma unroll
                for (int s = 0; s < 4; ++s) if (s <= l) yd += cbm[l][s] * xs[s];
                const float z = bf1(xzl[2048 + l * 512 + wave * 64 + pp]);
                const float y = (v * ecs[l] + yd + dsk * xs[l]) * siluf_(z);
                if (nq == 0) { sq[l] += y * y; so[(size_t)l * DI + pp] = (bf16)(pk2(y, 0.f) & 0xffffu); } }
        }
#pragma unroll
        for (int u = 0; u < 4; ++u)
#pragma unroll
            for (int q = 0; q < 2; ++q) S[u][q] = Sn[u][q];
    }
#pragma unroll
    for (int l = 0; l < 4; ++l) { const float s = wave_sum(sq[l]); if (lane == 0) ex[l * 8 + wave] = s; }
    LDS_WAIT(); VM_WAIT();
    __syncthreads();
    if (lane < 32) {
        const int l = lane >> 3, chn = lane & 7;
        float tot = 0.f;
#pragma unroll
        for (int w = 0; w < 8; ++w) tot += ex[l * 8 + w];
        const float rs = rsqrtf(tot * (1.f / 512.f) + EPS);
        const f32x4 g0 = *(const f32x4*)(p.in[19] + h * 64 + 8 * chn), g1 = *(const f32x4*)(p.in[19] + h * 64 + 8 * chn + 4);
        bf16* q = so + (size_t)l * DI + 8 * chn; const v4u w = *(const v4u*)q;
        v4u o; o.x = pk2(bf_lo(w.x) * rs * g0[0], bf_hi(w.x) * rs * g0[1]); o.y = pk2(bf_lo(w.y) * rs * g0[2], bf_hi(w.y) * rs * g0[3]);
        o.z = pk2(bf_lo(w.z) * rs * g1[0], bf_hi(w.z) * rs * g1[1]); o.w = pk2(bf_lo(w.w) * rs * g1[2], bf_hi(w.w) * rs * g1[3]);
        *(v4u*)q = o;
    }
    __syncthreads();
}

#ifndef ATTN_GROUPED
#define ATTN_GROUPED 0
#endif
#ifndef N_PHASES
#define N_PHASES 12
#endif
#ifndef ONE_LAUNCH
#define ONE_LAUNCH 1
#endif
__global__ void __launch_bounds__(NTHR, 2) fwd_kernel(Params p) {
    extern __shared__ __attribute__((aligned(16))) unsigned char lds_raw[];
    LAS unsigned char* lds = (LAS unsigned char*)lds_raw;
    const int wave = __builtin_amdgcn_readfirstlane((int)threadIdx.x >> 6);
#define LANE_ID() ({ int l_; asm volatile("v_mbcnt_lo_u32_b32 %0, -1, 0\n\tv_mbcnt_hi_u32_b32 %0, -1, %0" : "=v"(l_)); l_; })
    const int G = gridDim.x, blk = blockIdx.x;
    const int gw = blk * NWAVES + wave, ngw = G * NWAVES;
    unsigned char* ws = p.ws;
    volatile LAS unsigned* MISC = (volatile LAS unsigned*)(lds + MISC_OFF);
    { const int tid0 = wave * 64 + LANE_ID(); for (int u = tid0; u < (LDS_BYTES - CTL_OFF) / 4; u += NTHR) ((LAS unsigned*)(lds + CTL_OFF))[u] = 0u; }
    __syncthreads();
    XcdBarrier bar; bar.bar = (unsigned*)(ws + WS_CTL) + CW_BAR; bar.x = 0; bar.st = nullptr;
#if ONE_LAUNCH
    bar = xcd_barrier_post((unsigned*)(ws + WS_CTL) + CW_BAR, MISC + 8);
#endif
    float* const SSQP = (float*)(ws + WS_CTL + 262144);
    const int lo = p.ph_lo, hi = p.ph_hi;
#ifdef DIAG_A
    unsigned long long* stp = (unsigned long long*)(ws + WS_CTL + 65536);
#define STAMP(i) do { if (blk == 0 && threadIdx.x == 0) stp[i] = __builtin_amdgcn_s_memrealtime(); } while (0)
#else
#define STAMP(i) do { } while (0)
#endif
    STAMP(0);
#ifndef PH_MASK
#define PH_MASK 0xFFF
#endif
#define IN(k) (((PH_MASK >> (k)) & 1) && lo <= (k) && (k) < hi)
#ifndef BAR_REP
#define BAR_REP 1
#endif
#define SEAM(k) do { if (IN(k) && IN((k) + 1)) { _Pragma("unroll") for (int br_ = 0; br_ < BAR_REP; ++br_) xcd_barrier(bar); } } while (0)
#ifndef DBL_MASK
#define DBL_MASK 0
#endif
#define REP(b) _Pragma("unroll") for (int rep_ = 0; rep_ < (((DBL_MASK >> (b)) & 1) ? 2 : 1); ++rep_)

    if (IN(0)) { const int lane = LANE_ID(); REP(0) phase_prologue(p, lds, gw, ngw, wave, lane); }
    SEAM(0); STAMP(1);
    if (IN(1)) REP(1) {
        pg8::Gemm g{(const bf16*)(ws + WS_XN), (const bf16*)(ws + WS_WIN), MT, NIN, DM}; pg8::StaticOrder S; S.init(MT, NIN, G, blk);
        BigEpi<FIn> E{FIn{(bf16*)(ws + WS_PROJ), (float*)(ws + WS_PF)}, 0, nullptr};
        pg8::gemm_phase<BigEpi<FIn>, pg8::StaticOrder, true, true>(lds, g, S, E);
    }
    SEAM(1); STAMP(2);
    if (IN(2)) REP(2) {
        const int lane = LANE_ID();
        REP(15) {
            for (int r = gw; r < TP; r += ngw) p2_row(p, r, lane);
            if (ngw >= TS) { if (gw >= ngw - TS) p2_row(p, TP + gw - (ngw - TS), lane); } else for (int r = TP + gw; r < MT; r += ngw) p2_row(p, r, lane);
        }
        STAMP(23);
        REP(16) for (int u = gw; u < (TP / CONV_TOK) * 12; u += ngw) conv_unit_prompt(p, u, lds + wave * 16384, lane);
        for (int u = gw; u < NB * 12; u += ngw) conv_unit_sample(p, u, lane);
    }
    SEAM(2); STAMP(3);
    if (IN(3)) {
        const int lane = LANE_ID();
#ifndef P3S
#define P3S 15
#endif
        REP(3) if (P3S & 1) for (int u = blk; u < 2176; u += G) score_unit_prompt(p, 2175 - u, lds + 32768, wave, lane);
        REP(3) if (P3S & 2) {
            const int nheavy = 2176 % G, nlw = (G - nheavy) * NWAVES;
            if (nheavy == 0) { for (int j = gw; j < NB * 13; j += ngw) score_job_sample(p, j, lane); }
            else if (blk >= nheavy) { for (int j = (blk - nheavy) * NWAVES + wave; j < NB * 13; j += nlw) score_job_sample(p, j, lane); }
        }
        STAMP(20);
        REP(4) if (P3S & 4) for (int j = gw; j < 64 * 64; j += ngw) ssd_chunk_state(p, j >> 6, j & 63, (LAS float*)(lds + wave * 1024), lane);
        __syncthreads();
        STAMP(21);
        REP(5) if (P3S & 8) for (int u = blk; u < NB * 8; u += G) ssd_sample_unit(p, u >> 3, u & 7, (LAS float*)(lds + 16384), (LAS bf16*)(lds + 20480), wave, lane);
    }
    SEAM(3); STAMP(4);
    if (IN(4)) {
        const int lane = LANE_ID(); const int tid = wave * 64 + lane;
        LAS unsigned* hist = (LAS unsigned*)(lds + wave * 16768); LAS unsigned* ck = hist + 1024; LAS unsigned short* ci = (LAS unsigned short*)(hist + 1024 + CAND_CAP + 64);
        REP(6) for (int j = gw; j < TP; j += ngw) select_row<false>(p, TP - 1 - j, hist, ck, ci, lane);
        REP(6) for (int j = gw; j < TS; j += ngw) select_row<true>(p, TP + j, hist, ck, ci, lane);
        STAMP(24);
        REP(7) ssd_state_scan(p, blk * NTHR + tid, G * NTHR);
    }
    SEAM(4); STAMP(5);
    if (IN(5)) {
        const int lane = LANE_ID();
#ifndef P5S
#define P5S 7
#endif
        REP(8) if (P5S & 1) for (int u = blk; u < 64 * 8; u += G) ssd_output_unit(p, u >> 3, u & 7, (LAS float*)(lds + wave * 1024), (LAS float*)(lds + 8192), (LAS float*)(lds + 16384 + wave * 8704), wave, lane);
        __syncthreads();
        STAMP(22);
        LAS unsigned char* vt = lds + wave * 9216; LAS int* selb = (LAS int*)(vt + 8192);
        REP(9) if (P5S & 2) for (int j = gw; j < TS * 4; j += ngw) attn_job<true>(p, TP + (j >> 2), j & 3, vt, lane);
        {
            const int xcd = blk & 7, g = xcd & 3, nwq = (G >> 2) * NWAVES;
            const int wq = ((blk >> 3) * 2 + (xcd >> 2)) * NWAVES + wave;
            float gq = fmaxf(fabsf(p.in[10][lane]), fabsf(p.in[10][64 + lane])), gk = fmaxf(fabsf(p.in[11][lane]), fabsf(p.in[11][64 + lane]));
#pragma unroll
            for (int o_ = 1; o_ < 64; o_ <<= 1) { gq = fmaxf(gq, __shfl_xor(gq, o_)); gk = fmaxf(gk, __shfl_xor(gk, o_)); }
            const float mb = 1.1f * 11.313708499f * 1.4426950408889634f * gq * gk;
            const bool fixedb = __builtin_amdgcn_readfirstlane(mb < 40.f ? 1 : 0) != 0;
            if (fixedb) {
                if (ATTN_GROUPED && (G & 7) == 0) { REP(9) if (P5S & 4) attn_prompt_loop<false, true>(p, wq, nwq, TP, g, mb, vt, selb, lane); }
                else { REP(9) if (P5S & 4) attn_prompt_loop<false, false>(p, gw, ngw, TP * 4, 0, mb, vt, selb, lane); }
            } else {
                attn_prompt_loop<true, false>(p, gw, ngw, TP * 4, 0, mb, vt, selb, lane);
            }
        }
    }
    SEAM(5); STAMP(6);
    if (IN(6)) REP(10) {
        pg8::Gemm g{(const bf16*)(ws + WS_AO), (const bf16*)(ws + WS_WPA), TP, DM, DM}; pg8::StaticOrder S; S.init(TP, DM, G, blk);
        const FPA F{(const bf16*)(ws + WS_PROJ), (bf16*)(ws + WS_MIX32)};
        BigEpi<FPA> E{F, 0, nullptr};
        pg8::gemm_phase<BigEpi<FPA>, pg8::StaticOrder, true, true>(lds, g, S, E);
        { const int lane = LANE_ID(); gemm_small(lds, (const bf16*)(ws + WS_AO) + (size_t)TP * DM, (const bf16*)(ws + WS_WPA), TS, DM, DM, F, TP, SSQP, G, blk, wave, lane); }
    }
    if (IN(6) && IN(7)) { VM_WAIT(); __syncthreads(); }
    if (IN(7)) REP(10) {
        pg8::Gemm g{(const bf16*)(ws + WS_SSMO), (const bf16*)(ws + WS_WPS), TP, DM, DI}; pg8::StaticOrder S; S.init(TP, DM, G, blk);
        const FPS F{(const bf16*)(ws + WS_PROJ), (const bf16*)(ws + WS_MIX32), (bf16*)(ws + WS_MIXB)};
        BigEpi<FPS> E{F, 0, nullptr};
        pg8::gemm_phase<BigEpi<FPS>, pg8::StaticOrder, true, true>(lds, g, S, E);
        { const int lane = LANE_ID(); gemm_small(lds, (const bf16*)(ws + WS_SSMO) + (size_t)TP * DI, (const bf16*)(ws + WS_WPS), TS, DM, DI, F, TP, SSQP, G, blk, wave, lane); }
    }
    SEAM(7); STAMP(8);
    if (IN(8)) REP(11) {
        pg8::Gemm g{(const bf16*)(ws + WS_MIXB), (const bf16*)(ws + WS_WOUT), TP, DM, DM}; pg8::StaticOrder S; S.init(TP, DM, G, blk);
        const FRes<true> F{p.in[0], p.in[1], nullptr, nullptr, (bf16*)(ws + WS_H)};
        BigEpi<FRes<true>> E{F, 0, SSQP};
        pg8::gemm_phase<BigEpi<FRes<true>>, pg8::StaticOrder, true, true>(lds, g, S, E);
        { const int lane = LANE_ID(); gemm_small(lds, (const bf16*)(ws + WS_MIXB) + (size_t)TP * DM, (const bf16*)(ws + WS_WOUT), TS, DM, DM, F, TP, SSQP, G, blk, wave, lane); }
    }
    SEAM(8); STAMP(9);
    if (IN(10)) REP(13) {
        pg8::Gemm g{(const bf16*)(ws + WS_H), (const bf16*)(ws + WS_WUP), TP, DFF, DM}; pg8::StaticOrder S; S.init(TP, DFF, G, blk);
        const FUp F{(bf16*)(ws + WS_U), SSQP};
        BigEpi<FUp> E{F, 0, nullptr};
        pg8::gemm_phase<BigEpi<FUp>, pg8::StaticOrder, true, true>(lds, g, S, E);
        { const int lane = LANE_ID(); gemm_small(lds, (const bf16*)(ws + WS_H) + (size_t)TP * DM, (const bf16*)(ws + WS_WUP), TS, DFF, DM, F, TP, SSQP, G, blk, wave, lane); }
    }
    SEAM(10); STAMP(11);
    if (IN(11)) REP(14) {
        pg8::Gemm g{(const bf16*)(ws + WS_U), (const bf16*)(ws + WS_WDN), TP, DM, DFF}; pg8::StaticOrder S; S.init(TP, DM, G, blk);
        const FRes<false> F{nullptr, nullptr, (const bf16*)(ws + WS_H), p.out + O_Y, nullptr};
        BigEpi<FRes<false>> E{F, 0, nullptr};
        pg8::gemm_phase<BigEpi<FRes<false>>, pg8::StaticOrder, true, true>(lds, g, S, E);
        { const int lane = LANE_ID(); gemm_small(lds, (const bf16*)(ws + WS_U) + (size_t)TP * DFF, (const bf16*)(ws + WS_WDN), TS, DM, DFF, F, TP, SSQP, G, blk, wave, lane); }
    }
#ifdef DIAG_A
    STAMP(12);
    xcd_barrier(bar);
    if (blk == 0 && threadIdx.x == 0) {
        const int ia[20] = {0, 1, 2, 3, 4, 5, 6, 8, 9, 10, 11, 3, 20, 21, 5, 22, 2, 23, 4, 24};
        const int ib[20] = {1, 2, 3, 4, 5, 6, 8, 9, 10, 11, 12, 20, 21, 4, 22, 6, 23, 3, 24, 5};
        const float ta = (float)(stp[ib[DIAG_A]] - stp[ia[DIAG_A]]) * 0.01f, tb = (float)(stp[ib[DIAG_B]] - stp[ia[DIAG_B]]) * 0.01f;
        p.out[O_Y] = 10.f * ta; p.out[O_IKS] = tb;
    }
#endif
#undef IN
#undef SEAM
}

extern "C" void kernel_launch(void* const* d_in, const int* in_sizes, int n_in, void* d_out, int out_size, void* d_ws, size_t ws_size, hipStream_t stream) {
    static int grid = 0;
    if (grid == 0) {
        if (n_in != 26 || (size_t)out_size != O_END || ws_size < WS_END3) { fprintf(stderr, "kernel_launch: unexpected shapes (n_in %d out %d ws %zu)\n", n_in, out_size, ws_size); grid = -1; return; }
        int dev = 0, cus = 0, per_cu = 0;
        if (hipGetDevice(&dev) != hipSuccess || hipDeviceGetAttribute(&cus, hipDeviceAttributeMultiprocessorCount, dev) != hipSuccess) { grid = -1; return; }
        if (hipFuncSetAttribute((const void*)fwd_kernel, hipFuncAttributeMaxDynamicSharedMemorySize, LDS_BYTES) != hipSuccess) { fprintf(stderr, "kernel_launch: hipFuncSetAttribute failed\n"); grid = -1; return; }
        if (hipOccupancyMaxActiveBlocksPerMultiprocessor(&per_cu, (const void*)fwd_kernel, NTHR, LDS_BYTES) != hipSuccess || per_cu < 1) fprintf(stderr, "kernel_launch: occupancy query reports %d\n", per_cu);
        (void)hipGetLastError();
        grid = cus;
    }
    if (grid < 0) return;
    (void)hipMemsetAsync((char*)d_ws + WS_CTL, 0, CTL_ZERO_BYTES, stream);
    Params a{};
    for (int i = 0; i < 26; ++i) a.in[i] = (const float*)d_in[i];
    a.out = (float*)d_out; a.ws = (unsigned char*)d_ws;
#if ONE_LAUNCH
    a.ph_lo = 0; a.ph_hi = N_PHASES;
    hipLaunchKernelGGL(fwd_kernel, dim3(grid), dim3(NTHR), LDS_BYTES, stream, a);
#else
    for (int ph = 0; ph < N_PHASES; ++ph) { a.ph_lo = ph; a.ph_hi = ph + 1; hipLaunchKernelGGL(fwd_kernel, dim3(grid), dim3(NTHR), LDS_BYTES, stream, a); }
#endif
}
```

```cpp
#include <hip/hip_runtime.h>
#include <cstdio>
#include <cstdint>
#define ONE_LAUNCH 1
namespace pg8 {
#define PG8_LAS __attribute__((address_space(3)))
typedef unsigned short bf16_t;
typedef short bf16x8 __attribute__((ext_vector_type(8)));
typedef float f32x4 __attribute__((ext_vector_type(4)));
typedef unsigned u32x4 __attribute__((ext_vector_type(4)));
constexpr int BM = 256, BK = 64, HALF = 128, HTB = HALF * BK * 2  , STAGE_BYTES = 8 * HTB, NXCD = 8, WGM = 8;

__host__ __device__ __forceinline__ int lds_byte(int r, int c) { const int st = (r >> 4) * 2 + (c >> 5), rr = r & 15, cc = c & 31, ob = rr * 64 + cc * 2; return st * 1024 + (ob ^ (((ob >> 9) & 1) << 5)); }
__host__ __device__ __forceinline__ void stage_rc(int b, int& R, int& C) { const int st = b / 1024, sb = b % 1024, swz = sb ^ (((sb >> 9) & 1) << 5); R = (st >> 1) * 16 + swz / 64; C = (st & 1) * 32 + (swz % 64) / 2; }
__host__ __device__ __forceinline__ int perm32(int rho) { const int n = rho >> 4, i = rho & 15; return 8 * (i >> 2) + 4 * n + (i & 3); }

struct Unit { int pm, pn; };
struct Gemm { const bf16_t* A; const bf16_t* Bt; int M, N, K; };

struct StaticOrder {
    int nM, nN, nwg, G, c;
    __host__ __device__ void init(int M, int N, int G_, int c_) { nM = M / BM; nN = N / BM; nwg = nM * nN; G = G_; c = c_; }
    __host__ __device__ bool next(int i, Unit& u) const {
        const long L = (long)i * G + c; if (L >= nwg) return false;
        int wgid = (int)L; { const int q = nwg / NXCD, r = nwg % NXCD, xcd = wgid % NXCD, off = wgid / NXCD; wgid = (xcd < r ? xcd * (q + 1) : r * (q + 1) + (xcd - r) * q) + off; }
        const int nig = WGM * nN, gid = wgid / nig, fm = gid * WGM, gsz = (nM - fm) < WGM ? (nM - fm) : WGM;
        u.pm = fm + ((wgid % nig) % gsz); u.pn = (wgid % nig) / gsz; return true;
    }
    __device__ __forceinline__ void a_ready(const Unit&) const {}
    __device__ __forceinline__ void done(const Unit&) const {}
};
__device__ __forceinline__ unsigned cvt_pk_bf16(float lo, float hi) { unsigned r; asm volatile("v_cvt_pk_bf16_f32 %0, %1, %2" : "=v"(r) : "v"(lo), "v"(hi)); return r; }
typedef float f32x2 __attribute__((ext_vector_type(2)));
template <class Epi, class Sched, bool ALIGN_EPI = false, bool SP2 = false>
__device__ __forceinline__ void gemm_phase(PG8_LAS unsigned char* lds, const Gemm g, const Sched& S, const Epi& E) {
    const int tid = threadIdx.x, wid = __builtin_amdgcn_readfirstlane(tid >> 6), lane = tid & 63, wr = wid >> 2, wc = wid & 3, fr = lane & 15, fq = lane >> 4;
    const int K = g.K, nt = K / BK;
    unsigned voffA[2], voffB[2];
#pragma unroll
    for (int i = 0; i < 2; ++i) { int R, C; stage_rc(tid * 16 + i * 8192, R, C); const int Rb = Epi::PERM ? ((R & ~31) + perm32(R & 31)) : R;
        voffA[i] = (unsigned)(R * K + C) * 2u; voffB[i] = (unsigned)(Rb * K + C) * 2u; }
    const size_t kstep = (size_t)(BK * 2);
    const size_t hstep = (size_t)HALF * K * 2;
    const size_t tstep = 2 * hstep;
    const unsigned ldsw = (unsigned)wid * 1024u;
    const int aoff = lds_byte(wr * 64 + fr, fq * 8), boff = lds_byte(wc * 32 + fr, fq * 8);
#define PG8_SA(b, h) (((b) * 2 + (h)) * HTB)
#define PG8_SB(b, h) ((4 + (b) * 2 + (h)) * HTB)
#define PG8_STAGE(bufoff, gbase, voff) do { _Pragma("unroll") for (int _i = 0; _i < 2; ++_i) \
        __builtin_amdgcn_global_load_lds((const unsigned*)((const char*)(gbase) + (voff)[_i]), (PG8_LAS unsigned*)(lds + (bufoff) + ldsw + _i * 8192), 16, 0, 0); } while (0)
#define PG8_LDA(dst, b, h) do { _Pragma("unroll") for (int m = 0; m < 4; ++m) _Pragma("unroll") for (int k = 0; k < 2; ++k) dst[m][k] = *(const PG8_LAS bf16x8*)(lds + PG8_SA(b, h) + aoff + m * 2048 + k * 1024); } while (0)
#define PG8_LDB(dst, b, h) do { _Pragma("unroll") for (int n = 0; n < 2; ++n) _Pragma("unroll") for (int k = 0; k < 2; ++k) dst[n][k] = *(const PG8_LAS bf16x8*)(lds + PG8_SB(b, h) + boff + n * 2048 + k * 1024); } while (0)
#define PG8_MMA(ai, bj, At, Bt) do { __builtin_amdgcn_s_setprio(1); _Pragma("unroll") for (int m = 0; m < 4; ++m) _Pragma("unroll") for (int n = 0; n < 2; ++n) _Pragma("unroll") for (int k = 0; k < 2; ++k) \
        acc[ai][bj][m][n] = __builtin_amdgcn_mfma_f32_16x16x32_bf16(Bt[n][k], At[m][k], acc[ai][bj][m][n], 0, 0, 0); __builtin_amdgcn_s_setprio(0); } while (0)
#define PG8_WAIT_V(n) asm volatile("s_waitcnt vmcnt(" #n ")" ::: "memory")
#define PG8_WAIT_L(n) asm volatile("s_waitcnt lgkmcnt(" #n ")" ::: "memory")
#define PG8_BAR __builtin_amdgcn_s_barrier()
#define PG8_SCHED __builtin_amdgcn_sched_barrier(0)
    Unit cur, nxt; int ui = 0;
    if (!S.next(0, cur)) return;
    f32x4 acc[2][2][4][2];
#pragma unroll
    for (int a = 0; a < 2; ++a)
#pragma unroll
        for (int b = 0; b < 2; ++b)
#pragma unroll
            for (int m = 0; m < 4; ++m)
#pragma unroll
                for (int n = 0; n < 2; ++n) acc[a][b][m][n] = (f32x4){0.f, 0.f, 0.f, 0.f};
    bf16x8 At[4][2], B0[2][2], B1[2][2];
    const char* cA = (const char*)g.A + (size_t)cur.pm * tstep; const char* cB = (const char*)g.Bt + (size_t)cur.pn * tstep;
    S.a_ready(cur);
    if constexpr (SP2) {
        PG8_STAGE(PG8_SB(0, 0), cB, voffB); PG8_STAGE(PG8_SB(0, 1), cB + hstep, voffB); PG8_STAGE(PG8_SA(0, 0), cA, voffA); PG8_STAGE(PG8_SA(0, 1), cA + hstep, voffA);
        if (wr == 1) PG8_BAR;
        PG8_WAIT_V(2); PG8_BAR;
        PG8_STAGE(PG8_SB(1, 0), cB + kstep, voffB); PG8_STAGE(PG8_SA(1, 0), cA + kstep, voffA); PG8_STAGE(PG8_SB(1, 1), cB + hstep + kstep, voffB);
        PG8_WAIT_V(6); PG8_BAR;
    } else {
        PG8_STAGE(PG8_SB(0, 0), cB, voffB); PG8_STAGE(PG8_SA(0, 0), cA, voffA); PG8_STAGE(PG8_SB(0, 1), cB + hstep, voffB); PG8_STAGE(PG8_SA(0, 1), cA + hstep, voffA);
        if (wr == 1) PG8_BAR;
        PG8_WAIT_V(4); PG8_BAR;
        PG8_STAGE(PG8_SB(1, 0), cB + kstep, voffB); PG8_STAGE(PG8_SA(1, 0), cA + kstep, voffA); PG8_STAGE(PG8_SB(1, 1), cB + hstep + kstep, voffB);
        PG8_WAIT_V(6); PG8_BAR;
    }
    for (;;) {
        const bool has_next = S.next(ui + 1, nxt);
        const char* nA = has_next ? (const char*)g.A + (size_t)nxt.pm * tstep : cA; const char* nB = has_next ? (const char*)g.Bt + (size_t)nxt.pn * tstep : cB;
        for (int t = 0; t < nt; t += 2) {
            const bool last = (t == nt - 2);
            const char* a1 = cA + (size_t)(t + 1) * kstep;
            const char* a2 = last ? nA : cA + (size_t)(t + 2) * kstep; const char* b2 = last ? nB : cB + (size_t)(t + 2) * kstep;
            const char* a3 = a2 + kstep; const char* b3 = b2 + kstep;
            if (last && has_next) S.a_ready(nxt);
            if constexpr (SP2) {
            PG8_LDB(B0, 0, 0); PG8_LDB(B1, 0, 1); PG8_SCHED; PG8_LDA(At, 0, 0); PG8_STAGE(PG8_SA(1, 1), a1 + hstep, voffA);
            PG8_WAIT_V(8); PG8_WAIT_L(0); PG8_BAR; PG8_MMA(0, 0, At, B0); PG8_MMA(0, 1, At, B1); PG8_BAR; PG8_SCHED;
            PG8_LDA(At, 0, 1); PG8_STAGE(PG8_SB(0, 0), b2, voffB); PG8_STAGE(PG8_SB(0, 1), b2 + hstep, voffB); PG8_STAGE(PG8_SA(0, 0), a2, voffA);
            PG8_WAIT_V(8); PG8_WAIT_L(0); PG8_BAR; PG8_MMA(1, 0, At, B0); PG8_MMA(1, 1, At, B1); PG8_BAR; PG8_SCHED;
            PG8_LDB(B0, 1, 0); PG8_LDB(B1, 1, 1); PG8_SCHED; PG8_LDA(At, 1, 0); PG8_STAGE(PG8_SA(0, 1), a2 + hstep, voffA);
            PG8_WAIT_V(8); PG8_WAIT_L(0); PG8_BAR; PG8_MMA(0, 0, At, B0); PG8_MMA(0, 1, At, B1); PG8_BAR; PG8_SCHED;
            PG8_LDA(At, 1, 1); PG8_STAGE(PG8_SB(1, 0), b3, voffB); PG8_STAGE(PG8_SB(1, 1), b3 + hstep, voffB); PG8_STAGE(PG8_SA(1, 0), a3, voffA);
            PG8_WAIT_V(8); PG8_WAIT_L(0); PG8_BAR; PG8_MMA(1, 0, At, B0); PG8_MMA(1, 1, At, B1); PG8_BAR; PG8_SCHED;
            } else {
            PG8_LDB(B0, 0, 0); PG8_SCHED; PG8_LDA(At, 0, 0); PG8_STAGE(PG8_SA(1, 1), a1 + hstep, voffA);
            PG8_WAIT_L(8); PG8_BAR; PG8_WAIT_L(0); PG8_MMA(0, 0, At, B0); PG8_BAR; PG8_SCHED;
            PG8_LDB(B1, 0, 1); PG8_STAGE(PG8_SB(0, 0), b2, voffB);
            PG8_BAR; PG8_WAIT_L(0); PG8_MMA(0, 1, At, B1); PG8_BAR;
            PG8_LDA(At, 0, 1); PG8_STAGE(PG8_SA(0, 0), a2, voffA);
            PG8_BAR; PG8_WAIT_L(0); PG8_MMA(1, 0, At, B0); PG8_BAR; PG8_SCHED;
            PG8_STAGE(PG8_SB(0, 1), b2 + hstep, voffB);
            PG8_WAIT_V(6); PG8_BAR; PG8_MMA(1, 1, At, B1); PG8_BAR;
            PG8_LDB(B0, 1, 0); PG8_SCHED; PG8_LDA(At, 1, 0); PG8_STAGE(PG8_SA(0, 1), a2 + hstep, voffA);
            PG8_WAIT_L(8); PG8_BAR; PG8_WAIT_L(0); PG8_MMA(0, 0, At, B0); PG8_BAR; PG8_SCHED;
            PG8_LDB(B1, 1, 1); PG8_STAGE(PG8_SB(1, 0), b3, voffB);
            PG8_BAR; PG8_WAIT_L(0); PG8_MMA(0, 1, At, B1); PG8_BAR;
            PG8_LDA(At, 1, 1); PG8_STAGE(PG8_SA(1, 0), a3, voffA);
            PG8_BAR; PG8_WAIT_L(0); PG8_MMA(1, 0, At, B0); PG8_BAR; PG8_SCHED;
            PG8_STAGE(PG8_SB(1, 1), b3 + hstep, voffB);
            PG8_WAIT_V(6); PG8_BAR; PG8_MMA(1, 1, At, B1); PG8_BAR;
            }
        }
        if constexpr (ALIGN_EPI) { if (wr == 0) PG8_BAR; }
        if constexpr (!Epi::AFTER_DRAIN) { E(acc, cur, wr, wc, fr, fq); S.done(cur); }
        if (!has_next) break;
#pragma unroll
        for (int a = 0; a < 2; ++a)
#pragma unroll
            for (int b = 0; b < 2; ++b)
#pragma unroll
                for (int m = 0; m < 4; ++m)
#pragma unroll
                    for (int n = 0; n < 2; ++n) acc[a][b][m][n] = (f32x4){0.f, 0.f, 0.f, 0.f};
        cur = nxt; cA = nA; cB = nB; ++ui;
        if constexpr (ALIGN_EPI) { if (wr == 1) PG8_BAR; }
    }
    PG8_WAIT_V(0);
    if constexpr (!ALIGN_EPI) { if (wr == 0) PG8_BAR; }
    PG8_BAR;
    if constexpr (Epi::AFTER_DRAIN) { E.fused(acc, cur, wr, wc, fr, fq, lds, wid, lane); S.done(cur); }
#undef PG8_SA
#undef PG8_SB
#undef PG8_STAGE
#undef PG8_LDA
#undef PG8_LDB
#undef PG8_MMA
#undef PG8_WAIT_V
#undef PG8_WAIT_L
#undef PG8_BAR
#undef PG8_SCHED
}
}

#define GAS __attribute__((address_space(1)))
#define LAS __attribute__((address_space(3)))
typedef unsigned short bf16;
typedef unsigned v4u __attribute__((ext_vector_type(4)));
typedef unsigned v2u __attribute__((ext_vector_type(2)));
typedef float f32x4 __attribute__((ext_vector_type(4)));
typedef float f32x2 __attribute__((ext_vector_type(2)));
typedef float f32x16 __attribute__((ext_vector_type(16)));
typedef short bf16x8 __attribute__((ext_vector_type(8)));
typedef short v4i16_t __attribute__((ext_vector_type(4)));

constexpr int NWAVES = 8, NTHR = 512;
constexpr int DM = 2048, TP = 8192, TS = 512, MT = TP + TS, NB = 128, DSEQ = 4, PAST = 2048;
constexpr int NIN_SRC = 18576, NIN = 18688;
constexpr int C_Q = 0, C_K = 2048, C_V = 2560, C_IQ = 3072, C_IK = 4096, C_DT = 4160, C_IW = 4224, C_Z = 4352, C_XBC = 8448, C_GA = 14592, C_GB = 16640;
constexpr int PF_LD = 1280, PF_K = 0, PF_V = 512, PF_IK = 1024, PF_DT = 1088, PF_IW = 1152;
constexpr int DI = 4096, CONVD = 6144, DFF = 8192, NPOOLROWS = 2560 * 128;
constexpr int SCS_LD = 2112, NKS = PAST + DSEQ;
constexpr float EPS = 1e-6f;
constexpr size_t O_Y = 0, O_KP = 17825792, O_VP = 22020096, O_IKP = 26214400, O_CVP = 26738688, O_SSP = 26757120,
                 O_KS = 27281408, O_VS = 27543552, O_IKS = 27805696, O_CVS = 27838464, O_SSS = 30197760, O_END = 97306624;
constexpr size_t MiB = 1u << 20;
constexpr size_t WS_CTL = 0, CTL_ZERO_BYTES = 1 * MiB;
constexpr size_t WS_WIN = 2 * MiB, WS_WPA = 76 * MiB, WS_WPS = 84 * MiB, WS_WOUT = 100 * MiB, WS_WUP = 108 * MiB, WS_WDN = 140 * MiB;
constexpr size_t WS_XN = 172 * MiB, WS_PROJ = 208 * MiB, WS_PF = 520 * MiB, WS_KB = 564 * MiB, WS_VB = 573 * MiB, WS_K8 = 564 * MiB, WS_V8 = 569 * MiB, WS_IKB = 582 * MiB, WS_IWB = 584 * MiB, WS_DTB = 585 * MiB;
constexpr size_t WS_XT = 588 * MiB  , WS_BROW = 652 * MiB  , WS_CROW = 668 * MiB  , WS_BT = 684 * MiB  , WS_XBS = 700 * MiB  ;
constexpr size_t WS_SC = 708 * MiB  , WS_SCS = 964 * MiB  , WS_SEL = 970 * MiB  , WS_CNT = 979 * MiB, WS_AO = 980 * MiB  ;
constexpr size_t WS_CS = 1016 * MiB  , WS_CSL = 1144 * MiB, WS_STIN = 1145 * MiB  , WS_SSMO = 1210 * MiB  ;
constexpr size_t WS_MIX32 = 1280 * MiB  , WS_MIXB = 1348 * MiB  , WS_H = 1384 * MiB  , WS_HN = 1452 * MiB  , WS_U = 1488 * MiB  , WS_END = 1626 * MiB;
constexpr size_t WS_QB = 1626 * MiB  , WS_IQB = 1660 * MiB  , WS_END2 = 1678 * MiB;
constexpr size_t WS_ROPE = 1678 * MiB  , WS_ROPE2 = 1683 * MiB, WS_END3 = 1686 * MiB;
constexpr int NPOS = TP + DSEQ;
constexpr int CW_BAR = 4096;
constexpr int LDS_BYTES = 147456, RING_BYTES = 131072, CTL_OFF = 139264, MISC_OFF = CTL_OFF + 320;

struct Params {
    const float* in[26]; float* out; unsigned char* ws; int ph_lo, ph_hi;
};

#define LDS_WAIT() asm volatile("s_waitcnt lgkmcnt(0)" ::: "memory")
#define VM_WAIT() asm volatile("s_waitcnt vmcnt(0)" ::: "memory")
#define MFMA16S(a, b, c) __builtin_amdgcn_mfma_f32_16x16x32_bf16((a), (b), (c), 0, 0, 0)
__device__ __forceinline__ unsigned pk2(float lo, float hi) { return pg8::cvt_pk_bf16(lo, hi); }
__device__ __forceinline__ float bf_lo(unsigned w) { return __uint_as_float(w << 16); }
__device__ __forceinline__ float bf_hi(unsigned w) { return __uint_as_float(w & 0xffff0000u); }
__device__ __forceinline__ float bf1(bf16 b) { return __uint_as_float(((unsigned)b) << 16); }
__device__ __forceinline__ float sigmoidf_(float x) { return __builtin_amdgcn_rcpf(1.f + __expf(-x)); }
__device__ __forceinline__ float siluf_(float x) { return x * __builtin_amdgcn_rcpf(1.f + __expf(-x)); }
__device__ __forceinline__ float wave_sum(float v) {
#pragma unroll
    for (int o = 1; o < 64; o <<= 1) v += __shfl_xor(v, o);
    return v;
}
#define DPP_F(x, ctrl) __int_as_float(__builtin_amdgcn_update_dpp(0, __float_as_int(x), (ctrl), 0xf, 0xf, false))
__device__ __forceinline__ float sum16(float x) { x += DPP_F(x, 0x128); x += DPP_F(x, 0x124); x += DPP_F(x, 0x122); x += DPP_F(x, 0x121); return x; }
__device__ __forceinline__ float sum4(float x) { x += DPP_F(x, 0xB1); x += DPP_F(x, 0x4E); return x; }
__device__ __forceinline__ float sum2(float x) { x += DPP_F(x, 0xB1); return x; }
__device__ __forceinline__ const float* xrow_ptr(const Params& p, int r) { return r < TP ? p.in[0] + (size_t)r * DM : p.in[1] + (size_t)(r - TP) * DM; }

struct LdNone {};
struct FIn {
    static constexpr bool WANT_SSQ = false; static constexpr int BATCH = 16; typedef LdNone Ld;
    bf16* P; float* F;
    __device__ __forceinline__ Ld load(int, int) const { return Ld{}; }
    __device__ __forceinline__ float finish(int row, int col, f32x4 v0, f32x4 v1, const Ld&, int ctile) const {
        if ((ctile >= 8 && ctile < 12) || ctile == 16) { float* rp = F + (size_t)row * PF_LD + (ctile == 16 ? 1024 + col - C_IK : col - C_K); *(f32x4*)rp = v0; *(f32x4*)(rp + 4) = v1; }
        else { v4u w; w.x = pk2(v0[0], v0[1]); w.y = pk2(v0[2], v0[3]); w.z = pk2(v1[0], v1[1]); w.w = pk2(v1[2], v1[3]); *(v4u*)(P + (size_t)row * NIN + col) = w; }
        return 0.f;
    }
};
struct LdG { v4u g; };
struct FPA {
    static constexpr bool WANT_SSQ = false; static constexpr int BATCH = 16; typedef LdG Ld;
    const bf16* P; bf16* MX;
    __device__ __forceinline__ Ld load(int row, int col) const { return Ld{*(const v4u*)(P + (size_t)row * NIN + C_GA + col)}; }
    __device__ __forceinline__ float finish(int row, int col, f32x4 v0, f32x4 v1, const Ld& ld, int) const {
        const v4u g = ld.g; v4u w;
        w.x = pk2(sigmoidf_(bf_lo(g.x)) * v0[0], sigmoidf_(bf_hi(g.x)) * v0[1]); w.y = pk2(sigmoidf_(bf_lo(g.y)) * v0[2], sigmoidf_(bf_hi(g.y)) * v0[3]);
        w.z = pk2(sigmoidf_(bf_lo(g.z)) * v1[0], sigmoidf_(bf_hi(g.z)) * v1[1]); w.w = pk2(sigmoidf_(bf_lo(g.w)) * v1[2], sigmoidf_(bf_hi(g.w)) * v1[3]);
        *(v4u*)(MX + (size_t)row * DM + col) = w;
        return 0.f;
    }
};
struct LdGM { v4u g; v4u a; };
struct FPS {
    static constexpr bool WANT_SSQ = false; static constexpr int BATCH = 8; typedef LdGM Ld;
    const bf16* P; const bf16* MX; bf16* MB;
    __device__ __forceinline__ Ld load(int row, int col) const { return Ld{*(const v4u*)(P + (size_t)row * NIN + C_GB + col), *(const v4u*)(MX + (size_t)row * DM + col)}; }
    __device__ __forceinline__ float finish(int row, int col, f32x4 v0, f32x4 v1, const Ld& ld, int) const {
        const v4u g = ld.g, a = ld.a;
        v4u w;
        w.x = pk2(bf_lo(a.x) + sigmoidf_(bf_lo(g.x)) * v0[0], bf_hi(a.x) + sigmoidf_(bf_hi(g.x)) * v0[1]);
        w.y = pk2(bf_lo(a.y) + sigmoidf_(bf_lo(g.y)) * v0[2], bf_hi(a.y) + sigmoidf_(bf_hi(g.y)) * v0[3]);
        w.z = pk2(bf_lo(a.z) + sigmoidf_(bf_lo(g.z)) * v1[0], bf_hi(a.z) + sigmoidf_(bf_hi(g.z)) * v1[1]);
        w.w = pk2(bf_lo(a.w) + sigmoidf_(bf_lo(g.w)) * v1[2], bf_hi(a.w) + sigmoidf_(bf_hi(g.w)) * v1[3]);
        *(v4u*)(MB + (size_t)row * DM + col) = w;
        return 0.f;
    }
};
template <bool S_> struct LdR;
template <> struct LdR<true> { f32x4 x0, x1; };
template <> struct LdR<false> { v4u h; };
template <bool SSQ_>
struct FRes {
    static constexpr bool WANT_SSQ = SSQ_; static constexpr int BATCH = 8; typedef LdR<SSQ_> Ld;
    const float* b0; const float* b1; const bf16* hb; float* O; bf16* HB;
    __device__ __forceinline__ Ld load(int row, int col) const {
        if constexpr (SSQ_) { const float* bp = (row < TP ? b0 + (size_t)row * DM : b1 + (size_t)(row - TP) * DM) + col; return Ld{*(const f32x4*)bp, *(const f32x4*)(bp + 4)}; }
        else return Ld{*(const v4u*)(hb + (size_t)row * DM + col)};
    }
    __device__ __forceinline__ float finish(int row, int col, f32x4 v0, f32x4 v1, const Ld& ld, int) const {
        if constexpr (!SSQ_) {
            const v4u h = ld.h; float* op = O + (size_t)row * DM + col;
            *(f32x4*)op = (f32x4){bf_lo(h.x) + v0[0], bf_hi(h.x) + v0[1], bf_lo(h.y) + v0[2], bf_hi(h.y) + v0[3]};
            *(f32x4*)(op + 4) = (f32x4){bf_lo(h.z) + v1[0], bf_hi(h.z) + v1[1], bf_lo(h.w) + v1[2], bf_hi(h.w) + v1[3]};
            return 0.f;
        } else {
            const f32x4 x0 = ld.x0 + v0, x1 = ld.x1 + v1;
            v4u hw; hw.x = pk2(x0[0], x0[1]); hw.y = pk2(x0[2], x0[3]); hw.z = pk2(x1[0], x1[1]); hw.w = pk2(x1[2], x1[3]);
            *(v4u*)(HB + (size_t)row * DM + col) = hw;
            return ((x0[0] * x0[0] + x0[1] * x0[1]) + (x0[2] * x0[2] + x0[3] * x0[3])) + ((x1[0] * x1[0] + x1[1] * x1[1]) + (x1[2] * x1[2] + x1[3] * x1[3]));
        }
    }
};
struct LdS { float s; };
struct FUp {
    static constexpr bool WANT_SSQ = false; static constexpr int BATCH = 16; typedef LdS Ld;
    bf16* U; const float* ssq;
    __device__ __forceinline__ Ld load(int row, int) const { return Ld{ssq[row]}; }
    __device__ __forceinline__ float finish(int row, int col, f32x4 v0, f32x4 v1, const Ld& ld, int) const {
        const float rs = rsqrtf(ld.s * (1.f / DM) + EPS);
#pragma unroll
        for (int j = 0; j < 4; ++j) { const float a = fmaxf(v0[j] * rs, 0.f), b = fmaxf(v1[j] * rs, 0.f); v0[j] = a * a; v1[j] = b * b; }
        v4u w; w.x = pk2(v0[0], v0[1]); w.y = pk2(v0[2], v0[3]); w.z = pk2(v1[0], v1[1]); w.w = pk2(v1[2], v1[3]);
        *(v4u*)(U + (size_t)row * DFF + col) = w;
        return 0.f;
    }
};
template <class F> struct BigEpi {
    static constexpr bool PERM = true, AFTER_DRAIN = false;
    F f; int row_off; float* ssq;
    __device__ __forceinline__ void operator()(const pg8::f32x4 (&acc)[2][2][4][2], const pg8::Unit& u, int wr, int wc, int fr, int fq) const {
        const int row0 = row_off + u.pm * 256 + wr * 64 + fr, c0 = u.pn * 256 + wc * 32 + 8 * fq, ctile = u.pn;
        constexpr int NBT = F::BATCH;
#pragma unroll
        for (int q0 = 0; q0 < 16; q0 += NBT) {
            typename F::Ld ld[NBT];
#pragma unroll
            for (int k = 0; k < NBT; ++k) { const int q = q0 + k; ld[k] = f.load(row0 + (q >> 3) * 128 + ((q >> 1) & 3) * 16, c0 + (q & 1) * 128); }
#pragma unroll
            for (int k = 0; k < NBT; k += 2) {
                const int q = q0 + k, ai = q >> 3, m = (q >> 1) & 3, row = row0 + ai * 128 + m * 16;
                float s = f.finish(row, c0, acc[ai][0][m][0], acc[ai][0][m][1], ld[k], ctile);
                s += f.finish(row, c0 + 128, acc[ai][1][m][0], acc[ai][1][m][1], ld[k + 1], ctile);
                if (F::WANT_SSQ) { s += __shfl_xor(s, 16); s += __shfl_xor(s, 32); if (fq == 0) atomicAdd(ssq + row, s); }
            }
        }
    }
};
__device__ __forceinline__ unsigned sg_off(unsigned row, unsigned ch) { return row * 128u + ((ch ^ (row & 7u)) << 4); }
template <class F>
__device__ __forceinline__ void gemm_small(LAS unsigned char* lds, const bf16* A, const bf16* Bt, int Ms, int N, int K, const F& f, int row_off, float* ssq, int G, int blk, int wave, int lane) {
    const int tid = wave * 64 + lane, nMt = Ms / 64, total = nMt * (N / 64), nk = K / 64;
    const int lrow = tid >> 3, lch = tid & 7;
    const int ti = wave >> 1, tj0 = 2 * (wave & 1), r = lane & 15, kq = lane >> 4;
    LAS float* ct = (LAS float*)(lds + 32768);
    for (int t = blk; t < total; t += G) {
        const int tn = t / nMt, tm = t - tn * nMt;
        const bf16* ap = A + (size_t)(tm * 64 + lrow) * K + 8 * lch; const bf16* bp = Bt + (size_t)(tn * 64 + lrow) * K + 8 * lch;
        v4u ra[4], rb[4];
#pragma unroll
        for (int d = 0; d < 4; ++d) { if (d < nk) { ra[d] = *(const v4u*)(ap + 64 * d); rb[d] = *(const v4u*)(bp + 64 * d); } }
        f32x4 acc0 = (f32x4){0.f, 0.f, 0.f, 0.f}, acc1 = (f32x4){0.f, 0.f, 0.f, 0.f};
        for (int s0 = 0; s0 < nk; s0 += 4) {
#pragma unroll
            for (int d = 0; d < 4; ++d) {
                const int s = s0 + d;
                LAS unsigned char* st = lds + (d & 1) * 16384;
                *(LAS v4u*)(st + sg_off(lrow, lch)) = ra[d]; *(LAS v4u*)(st + 8192 + sg_off(lrow, lch)) = rb[d];
                if (s + 4 < nk) { ra[d] = *(const v4u*)(ap + 64 * (s + 4)); rb[d] = *(const v4u*)(bp + 64 * (s + 4)); }
                __syncthreads();
#pragma unroll
                for (int ks = 0; ks < 2; ++ks) {
                    const bf16x8 af = *(const LAS bf16x8*)(st + sg_off(16 * ti + r, 4 * ks + kq));
                    const bf16x8 b0 = *(const LAS bf16x8*)(st + 8192 + sg_off(16 * tj0 + r, 4 * ks + kq));
                    const bf16x8 b1 = *(const LAS bf16x8*)(st + 8192 + sg_off(16 * tj0 + 16 + r, 4 * ks + kq));
                    acc0 = MFMA16S(af, b0, acc0); acc1 = MFMA16S(af, b1, acc1);
                }
            }
        }
#pragma unroll
        for (int i = 0; i < 4; ++i) { ct[(16 * ti + 4 * kq + i) * 68 + 16 * tj0 + r] = acc0[i]; ct[(16 * ti + 4 * kq + i) * 68 + 16 * tj0 + 16 + r] = acc1[i]; }
        __syncthreads();
        { const f32x4 v0 = *(const LAS f32x4*)(ct + lrow * 68 + 8 * lch), v1 = *(const LAS f32x4*)(ct + lrow * 68 + 8 * lch + 4);
          const typename F::Ld ld_ = f.load(row_off + tm * 64 + lrow, tn * 64 + 8 * lch);
          float sq_ = f.finish(row_off + tm * 64 + lrow, tn * 64 + 8 * lch, v0, v1, ld_, (tn * 64) >> 8);
          if (F::WANT_SSQ) { sq_ += __shfl_xor(sq_, 1); sq_ += __shfl_xor(sq_, 2); sq_ += __shfl_xor(sq_, 4); if (lch == 0) atomicAdd(ssq + row_off + tm * 64 + lrow, sq_); } }
        __syncthreads();
    }
}
#define XB_TMO      128
#define XB_XCNT(j)  (256  + 64 * (j))
#define XB_XSUB(j)  (1280 + 64 * (j))
#define XB_XGEN(j)  (2304 + 64 * (j))
#define XB_TOP      3328
#define XB_TOPGEN   3392
#define XCD_BAR_WORDS 3456
#define XB_SPIN_CAP (1u << 18)

__device__ __forceinline__ unsigned xb_ld(unsigned* p)              { return __hip_atomic_load(p, __ATOMIC_RELAXED, __HIP_MEMORY_SCOPE_AGENT); }
__device__ __forceinline__ unsigned xb_add(unsigned* p, unsigned v) { return __hip_atomic_fetch_add(p, v, __ATOMIC_RELAXED, __HIP_MEMORY_SCOPE_AGENT); }
__device__ __forceinline__ unsigned xb_xcc_id() { return (unsigned)__builtin_amdgcn_s_getreg((3 << 11) | 20) & 0xFu; }
#define XB_SPIN(cond, bar) do { unsigned _sp = 0; while (cond) { __builtin_amdgcn_s_sleep(1); \
    if ((++_sp & 255u) == 0u) { if (xb_ld(&(bar)[XB_TMO])) break; if (_sp > XB_SPIN_CAP) { atomicAdd(&(bar)[XB_TMO], 1u); break; } } } } while (0)

struct XcdBarrier {
    unsigned* bar; unsigned x;
    volatile LAS unsigned* st;
};

__device__ __forceinline__ XcdBarrier xcd_barrier_post(unsigned* bar, volatile LAS unsigned* st) {
    XcdBarrier b; b.bar = bar; b.x = xb_xcc_id(); b.st = st;
    if (threadIdx.x == 0) (void)xb_add(&bar[XB_XCNT(b.x)], 1u);
    return b;
}
__device__ __forceinline__ void xcd_barrier_complete(unsigned* bar, unsigned x, unsigned& nloc, unsigned& nx) {
    const unsigned G = gridDim.x * gridDim.y * gridDim.z;
    unsigned sum, cnt, mine, sp = 0u;
    for (;;) {
        sum = 0u; cnt = 0u; mine = 0u;
#pragma unroll
        for (unsigned j = 0; j < 16; ++j) { const unsigned c = xb_ld(&bar[XB_XCNT(j)]); sum += c; cnt += (c > 0u) ? 1u : 0u; mine = (j == x) ? c : mine; }
        if (sum == G) break;
        __builtin_amdgcn_s_sleep(1);
        if ((++sp & 255u) == 0u) { if (xb_ld(&bar[XB_TMO])) break; if (sp > XB_SPIN_CAP) { atomicAdd(&bar[XB_TMO], 1u); break; } }
    }
    nloc = mine > 0u ? mine : 1u; nx = cnt > 0u ? cnt : 1u;
}

__device__ __forceinline__ void xcd_barrier(const XcdBarrier& b) {
    asm volatile("s_waitcnt vmcnt(0)" ::: "memory");
    __syncthreads();
    if (threadIdx.x == 0) {
        unsigned* bar = b.bar;
        __builtin_amdgcn_s_waitcnt(0);
        unsigned nloc = b.st[0], nx = b.st[1];
        if (nloc == 0u) { xcd_barrier_complete(bar, b.x, nloc, nx); b.st[0] = nloc; b.st[1] = nx; }
        const unsigned old = xb_add(&bar[XB_XSUB(b.x)], 1u);
        const unsigned gen = old / nloc;
        if (old + 1u == (gen + 1u) * nloc) {
            __builtin_amdgcn_fence(__ATOMIC_RELEASE, "agent");
            asm volatile("s_waitcnt vmcnt(0)" ::: "memory");
            const unsigned og = xb_add(&bar[XB_TOP], 1u);
            const unsigned tg = og / nx;
            if (og + 1u == (tg + 1u) * nx) xb_add(&bar[XB_TOPGEN], 1u);
            else XB_SPIN(xb_ld(&bar[XB_TOPGEN]) == tg, bar);
            __builtin_amdgcn_fence(__ATOMIC_ACQUIRE, "agent");
            xb_add(&bar[XB_XGEN(b.x)], 1u);
            asm volatile("s_waitcnt vmcnt(0)" ::: "memory");
        } else {
            XB_SPIN(xb_ld(&bar[XB_XGEN(b.x)]) == gen, bar);
            __builtin_amdgcn_fence(__ATOMIC_ACQUIRE, "agent");
            asm volatile("s_waitcnt vmcnt(0)" ::: "memory");
        }
    }
    __syncthreads();
}

constexpr float LOG2_THETA = 13.287712379549449f;
__device__ __forceinline__ int src_col_in(int nd) {
    if (nd < 4160) return nd;
    if (nd < 4224) return 14416 + (nd - 4160);
    if (nd < 4240) return 4160 + (nd - 4224);
    if (nd < 4352) return -1;
    if (nd < 8448) return 4176 + (nd - 4352);
    if (nd < 14592) return 8272 + (nd - 8448);
    if (nd < 16640) return 14480 + (nd - 14592);
    return 16528 + (nd - 16640);
}
struct TItem { const float* W; bf16* WT; const float* ks; int K, Nsrc, k0, n0; bool map; };
__device__ __forceinline__ void titem_load(const TItem& t, f32x4 (&v)[16], int lane) {
    const int nd = t.n0 + 4 * (lane & 15);
    const int sc = t.map ? src_col_in(nd) : nd;
#pragma unroll
    for (int i = 0; i < 16; ++i) { const int kk = (lane >> 4) + 4 * i;
        v[i] = (sc >= 0) ? *(const f32x4*)(t.W + (size_t)(t.k0 + kk) * t.Nsrc + sc) : (f32x4){0.f, 0.f, 0.f, 0.f}; }
}
__device__ __forceinline__ void titem_finish(const TItem& t, f32x4 (&v)[16], LAS float* scr, int lane) {
    if (t.ks) {
#pragma unroll
        for (int i = 0; i < 16; ++i) v[i] = v[i] * t.ks[t.k0 + (lane >> 4) + 4 * i];
    }
#pragma unroll
    for (int i = 0; i < 16; ++i) { const int kk = (lane >> 4) + 4 * i; LAS float* d = scr + kk * 65 + 4 * (lane & 15);
        d[0] = v[i][0]; d[1] = v[i][1]; d[2] = v[i][2]; d[3] = v[i][3]; }
    LDS_WAIT();
    const int c = lane & 7;
#pragma unroll
    for (int j = 0; j < 8; ++j) { const int n = (lane >> 3) + 8 * j; const LAS float* s = scr + (8 * c) * 65 + n;
        v4u o; o.x = pk2(s[0 * 65], s[1 * 65]); o.y = pk2(s[2 * 65], s[3 * 65]); o.z = pk2(s[4 * 65], s[5 * 65]); o.w = pk2(s[6 * 65], s[7 * 65]);
        *(v4u*)(t.WT + (size_t)(t.n0 + n) * t.K + t.k0 + 8 * c) = o; }
    LDS_WAIT();
}
__device__ __forceinline__ void rms_row_load(f32x4 (&v)[8], const float* xrow, int lane) {
#pragma unroll
    for (int j = 0; j < 8; ++j) v[j] = *(const f32x4*)(xrow + 4 * lane + 256 * j);
}
__device__ __forceinline__ void rms_row_finish(const f32x4 (&v)[8], const float* g, bf16* orow, int lane) {
    float s = 0.f;
#pragma unroll
    for (int j = 0; j < 8; ++j) s += (v[j][0] * v[j][0] + v[j][1] * v[j][1]) + (v[j][2] * v[j][2] + v[j][3] * v[j][3]);
    const float r = rsqrtf(wave_sum(s) * (1.f / DM) + EPS);
#pragma unroll
    for (int j = 0; j < 8; ++j) { const f32x4 gg = *(const f32x4*)(g + 4 * lane + 256 * j);
        v2u o; o.x = pk2(v[j][0] * r * gg[0], v[j][1] * r * gg[1]); o.y = pk2(v[j][2] * r * gg[2], v[j][3] * r * gg[3]);
        *(v2u*)(orow + 4 * lane + 256 * j) = o; }
}
__device__ __forceinline__ void phase_prologue(const Params& p, LAS unsigned char* lds, int gw, int ngw, int wave, int lane) {
    LAS float* scr = (LAS float*)(lds + wave * 16640);
    unsigned char* ws = p.ws;
    constexpr int I_IN = (DM / 64) * (NIN / 64), I_PA = 32 * 32, I_PS = 64 * 32, I_OUT = 32 * 32, I_UP = 32 * 128, I_DN = 128 * 32;
    constexpr int NIT = I_IN + I_PA + I_PS + I_OUT + I_UP + I_DN;
    auto decode = [&](int it) -> TItem {
        int r = it; TItem t; t.ks = nullptr; t.map = false; int nblk;
        if (r < I_IN) { t.W = p.in[9]; t.K = DM; t.Nsrc = NIN_SRC; t.WT = (bf16*)(ws + WS_WIN); nblk = NIN / 64; t.map = true; }
        else if ((r -= I_IN) < I_PA) { t.W = p.in[20]; t.K = DM; t.Nsrc = DM; t.WT = (bf16*)(ws + WS_WPA); nblk = DM / 64; }
        else if ((r -= I_PA) < I_PS) { t.W = p.in[21]; t.K = DI; t.Nsrc = DM; t.WT = (bf16*)(ws + WS_WPS); nblk = DM / 64; }
        else if ((r -= I_PS) < I_OUT) { t.W = p.in[22]; t.K = DM; t.Nsrc = DM; t.WT = (bf16*)(ws + WS_WOUT); nblk = DM / 64; }
        else if ((r -= I_OUT) < I_UP) { t.W = p.in[24]; t.K = DM; t.Nsrc = DFF; t.WT = (bf16*)(ws + WS_WUP); nblk = DFF / 64; t.ks = p.in[23]; }
        else { r -= I_UP; t.W = p.in[25]; t.K = DFF; t.Nsrc = DM; t.WT = (bf16*)(ws + WS_WDN); nblk = DM / 64; }
        const int kb = r / nblk; t.k0 = kb * 64; t.n0 = (r - kb * nblk) * 64; return t;
    };
    if (gw < NIT) {
        f32x4 va[16], vb[16];
        TItem ta = decode(gw), tb = ta;
        titem_load(ta, va, lane);
        for (int it = gw; it < NIT; it += 2 * ngw) {
            const bool hb = it + ngw < NIT;
            if (hb) { tb = decode(it + ngw); titem_load(tb, vb, lane); }
            titem_finish(ta, va, scr, lane);
            if (!hb) break;
            const bool ha = it + 2 * ngw < NIT;
            if (ha) { ta = decode(it + 2 * ngw); titem_load(ta, va, lane); }
            titem_finish(tb, vb, scr, lane);
        }
    }
    if (gw < MT) {
        f32x4 cv_[8], nv_[8];
        rms_row_load(cv_, xrow_ptr(p, gw), lane);
        for (int m = gw; m < MT; m += ngw) {
            const int mn = m + ngw;
#pragma unroll
            for (int j = 0; j < 8; ++j) nv_[j] = cv_[j];
            if (mn < MT) rms_row_load(nv_, xrow_ptr(p, mn), lane);
            rms_row_finish(cv_, p.in[8], (bf16*)(ws + WS_XN) + (size_t)m * DM, lane);
#pragma unroll
            for (int j = 0; j < 8; ++j) cv_[j] = nv_[j];
        }
    }
    for (int pr = gw; pr < NPOS; pr += ngw) {
        const float fpos = (float)(pr < TP ? pr : PAST + (pr - TP));
        const float a = fpos * exp2f(-(float)lane * (LOG2_THETA / 64.f));
        *(f32x2*)((float*)(ws + WS_ROPE) + ((size_t)pr * 64 + lane) * 2) = (f32x2){cosf(a), sinf(a)};
        if (lane < 32) { const float b = fpos * exp2f(-(float)lane * (LOG2_THETA / 32.f)); *(f32x2*)((float*)(ws + WS_ROPE2) + ((size_t)pr * 32 + lane) * 2) = (f32x2){cosf(b), sinf(b)}; }
    }
}

__device__ __forceinline__ void p2_row(const Params& p, int r, int lane) {
    unsigned char* ws = p.ws;
    bf16* prow = (bf16*)(ws + WS_PROJ) + (size_t)r * NIN;
    const float* frow = (const float*)(ws + WS_PF) + (size_t)r * PF_LD;
    const int prow_ = r < TP ? r : TP + ((r - TP) & 3);
    {
        const int hq = lane >> 2, pq = lane & 3;
        const float* g = p.in[10]; const float* tb = (const float*)(ws + WS_ROPE) + (size_t)prow_ * 128;
        v4u w[2][2];
#pragma unroll
        for (int a_ = 0; a_ < 2; ++a_)
#pragma unroll
            for (int b_ = 0; b_ < 2; ++b_) w[a_][b_] = *(const v4u*)(prow + C_Q + hq * 128 + 64 * b_ + 8 * (pq + 4 * a_));
        float x[2][2][8]; float ss = 0.f;
#pragma unroll
        for (int a_ = 0; a_ < 2; ++a_)
#pragma unroll
            for (int b_ = 0; b_ < 2; ++b_) { const unsigned ww[4] = {w[a_][b_].x, w[a_][b_].y, w[a_][b_].z, w[a_][b_].w};
#pragma unroll
                for (int j = 0; j < 4; ++j) { x[a_][b_][2 * j] = bf_lo(ww[j]); x[a_][b_][2 * j + 1] = bf_hi(ww[j]); ss += x[a_][b_][2 * j] * x[a_][b_][2 * j] + x[a_][b_][2 * j + 1] * x[a_][b_][2 * j + 1]; } }
        ss = sum4(ss);
        const float rr = rsqrtf(ss * (1.f / 128.f) + EPS);
        bf16* qo = (bf16*)(ws + WS_QB) + (size_t)r * DM + hq * 128;
#pragma unroll
        for (int a_ = 0; a_ < 2; ++a_) {
            const int i8 = 8 * (pq + 4 * a_);
            float o1[8], o2[8];
#pragma unroll
            for (int q4 = 0; q4 < 2; ++q4) {
                const f32x4 ga = *(const f32x4*)(g + i8 + 4 * q4), gb = *(const f32x4*)(g + 64 + i8 + 4 * q4);
                const f32x4 t0_ = *(const f32x4*)(tb + (i8 + 4 * q4) * 2), t1_ = *(const f32x4*)(tb + (i8 + 4 * q4) * 2 + 4);
                const float cc[4] = {t0_[0], t0_[2], t1_[0], t1_[2]}, sn[4] = {t0_[1], t0_[3], t1_[1], t1_[3]};
#pragma unroll
                for (int e = 0; e < 4; ++e) { const float x1 = x[a_][0][4 * q4 + e] * rr * ga[e], x2 = x[a_][1][4 * q4 + e] * rr * gb[e];
                    o1[4 * q4 + e] = x1 * cc[e] - x2 * sn[e]; o2[4 * q4 + e] = x2 * cc[e] + x1 * sn[e]; }
            }
            v4u u1, u2; u1.x = pk2(o1[0], o1[1]); u1.y = pk2(o1[2], o1[3]); u1.z = pk2(o1[4], o1[5]); u1.w = pk2(o1[6], o1[7]);
            u2.x = pk2(o2[0], o2[1]); u2.y = pk2(o2[2], o2[3]); u2.z = pk2(o2[4], o2[5]); u2.w = pk2(o2[6], o2[7]);
            *(v4u*)(qo + i8) = u1; *(v4u*)(qo + 64 + i8) = u2;
        }
    }
    float* outk = p.out + (r < TP ? O_KP + (size_t)r * 512 : O_KS + (size_t)(r - TP) * 512);
    float* outv = p.out + (r < TP ? O_VP + (size_t)r * 512 : O_VS + (size_t)(r - TP) * 512);
    {
        const int hk = lane >> 4, i4 = 4 * (lane & 15);
        const float* g = p.in[11]; const float* tb = (const float*)(ws + WS_ROPE) + (size_t)prow_ * 128;
        const f32x4 xa = *(const f32x4*)(frow + PF_K + hk * 128 + i4), xb = *(const f32x4*)(frow + PF_K + hk * 128 + 64 + i4);
        float ss = ((xa[0] * xa[0] + xa[1] * xa[1]) + (xa[2] * xa[2] + xa[3] * xa[3])) + ((xb[0] * xb[0] + xb[1] * xb[1]) + (xb[2] * xb[2] + xb[3] * xb[3]));
        ss = sum16(ss);
        const float rr = rsqrtf(ss * (1.f / 128.f) + EPS);
        const f32x4 ga = *(const f32x4*)(g + i4), gb = *(const f32x4*)(g + 64 + i4);
        const f32x4 t0_ = *(const f32x4*)(tb + i4 * 2), t1_ = *(const f32x4*)(tb + i4 * 2 + 4);
        const float cc[4] = {t0_[0], t0_[2], t1_[0], t1_[2]}, sn[4] = {t0_[1], t0_[3], t1_[1], t1_[3]};
        f32x4 o1, o2;
#pragma unroll
        for (int e = 0; e < 4; ++e) { const float x1 = xa[e] * rr * ga[e], x2 = xb[e] * rr * gb[e]; o1[e] = x1 * cc[e] - x2 * sn[e]; o2[e] = x2 * cc[e] + x1 * sn[e]; }
        *(f32x4*)(outk + hk * 128 + i4) = o1; *(f32x4*)(outk + hk * 128 + 64 + i4) = o2;
        if (r < TP) { unsigned char* k8 = ws + WS_K8 + (size_t)r * 512 + hk * 128 + i4;
            int w1 = __builtin_amdgcn_cvt_pk_fp8_f32(o1[0], o1[1], 0, false); w1 = __builtin_amdgcn_cvt_pk_fp8_f32(o1[2], o1[3], w1, true);
            int w2 = __builtin_amdgcn_cvt_pk_fp8_f32(o2[0], o2[1], 0, false); w2 = __builtin_amdgcn_cvt_pk_fp8_f32(o2[2], o2[3], w2, true);
            *(int*)k8 = w1; *(int*)(k8 + 64) = w2; }
    }
    {
#pragma unroll
        for (int j = 0; j < 2; ++j) { const int off = 4 * lane + 256 * j; const f32x4 v = *(const f32x4*)(frow + PF_V + off);
            *(f32x4*)(outv + off) = v;
            if (r < TP) { int w = __builtin_amdgcn_cvt_pk_fp8_f32(v[0], v[1], 0, false); w = __builtin_amdgcn_cvt_pk_fp8_f32(v[2], v[3], w, true); *(int*)(ws + WS_V8 + (size_t)r * 512 + off) = w; } }
    }
    const int j0 = 2 * (lane & 15);
    const f32x4 dt01 = *(const f32x4*)((const float*)(ws + WS_ROPE2) + ((size_t)prow_ * 32 + j0) * 2);
    const float d0 = dt01[0], t0 = dt01[1], d1 = dt01[2], t1 = dt01[3];
    {
        const int hi_ = lane >> 2, pq = lane & 3;
        const float* tb = (const float*)(ws + WS_ROPE2) + (size_t)prow_ * 64;
        const v4u w1 = *(const v4u*)(prow + C_IQ + hi_ * 64 + 8 * pq), w2 = *(const v4u*)(prow + C_IQ + hi_ * 64 + 32 + 8 * pq);
        const unsigned a4[4] = {w1.x, w1.y, w1.z, w1.w}, b4[4] = {w2.x, w2.y, w2.z, w2.w};
        unsigned u1[4], u2[4];
#pragma unroll
        for (int j = 0; j < 4; ++j) { const f32x4 t = *(const f32x4*)(tb + (8 * pq + 2 * j) * 2);
            const float x0 = bf_lo(a4[j]), x1 = bf_hi(a4[j]), y0 = bf_lo(b4[j]), y1 = bf_hi(b4[j]);
            u1[j] = pk2(x0 * t[0] - y0 * t[1], x1 * t[2] - y1 * t[3]); u2[j] = pk2(y0 * t[0] + x0 * t[1], y1 * t[2] + x1 * t[3]); }
        bf16* io = (bf16*)(ws + WS_IQB) + (size_t)r * 1024 + hi_ * 64 + 8 * pq;
        *(v4u*)io = (v4u){u1[0], u1[1], u1[2], u1[3]}; *(v4u*)(io + 32) = (v4u){u2[0], u2[1], u2[2], u2[3]};
    }
    {
        const f32x2 xa = *(const f32x2*)(frow + PF_IK + j0), xb = *(const f32x2*)(frow + PF_IK + 32 + j0);
        float s = (xa[0] + xa[1]) + (xb[0] + xb[1]);
        s = sum16(s);
        const float mean = s * (1.f / 64.f);
        const float e0 = xa[0] - mean, e1 = xa[1] - mean, e2 = xb[0] - mean, e3 = xb[1] - mean;
        float q = (e0 * e0 + e1 * e1) + (e2 * e2 + e3 * e3);
        q = sum16(q);
        const float rs = rsqrtf(q * (1.f / 64.f) + EPS);
        const float* g = p.in[12]; const float* b = p.in[13];
        const float x0 = e0 * rs * g[j0] + b[j0], x1 = e1 * rs * g[j0 + 1] + b[j0 + 1], y0 = e2 * rs * g[32 + j0] + b[32 + j0], y1 = e3 * rs * g[33 + j0] + b[33 + j0];
        const float o0 = x0 * d0 - y0 * t0, o1 = x1 * d1 - y1 * t1, o2 = y0 * d0 + x0 * t0, o3 = y1 * d1 + x1 * t1;
        if (lane < 16) {
            float* oi = p.out + (r < TP ? O_IKP + (size_t)r * 64 : O_IKS + (size_t)(r - TP) * 64);
            *(f32x2*)(oi + j0) = (f32x2){o0, o1}; *(f32x2*)(oi + 32 + j0) = (f32x2){o2, o3};
            bf16* ib = (bf16*)(ws + WS_IKB) + (size_t)r * 64;
            *(unsigned*)(ib + j0) = pk2(o0, o1); *(unsigned*)(ib + 32 + j0) = pk2(o2, o3);
        }
    }
    if (lane < 16) ((float*)(ws + WS_IWB))[(size_t)r * 16 + lane] = frow[PF_IW + lane] * (1.f / 32.f);
    {
        const float x = frow[PF_DT + lane] + p.in[16][lane];
        ((float*)(ws + WS_DTB))[(size_t)r * 64 + lane] = fmaxf(x, 0.f) + log1pf(expf(-fabsf(x)));
    }
}
constexpr int CONV_TOK = 16;
__device__ __forceinline__ void conv_unit_prompt(const Params& p, int unit, LAS unsigned char* stg  , int lane) {
    unsigned char* ws = p.ws;
    const int tb = unit / 12, slab = unit - tb * 12, tbase = tb * CONV_TOK, ch0 = slab * 512 + 8 * lane;
    const bf16* xb = (const bf16*)(ws + WS_PROJ) + C_XBC + ch0;
    float cw[4][8], cb[8];
#pragma unroll
    for (int i = 0; i < 4; ++i) { const f32x4 a = *(const f32x4*)(p.in[14] + (size_t)i * CONVD + ch0), b = *(const f32x4*)(p.in[14] + (size_t)i * CONVD + ch0 + 4);
        cw[i][0] = a[0]; cw[i][1] = a[1]; cw[i][2] = a[2]; cw[i][3] = a[3]; cw[i][4] = b[0]; cw[i][5] = b[1]; cw[i][6] = b[2]; cw[i][7] = b[3]; }
    { const f32x4 a = *(const f32x4*)(p.in[15] + ch0), b = *(const f32x4*)(p.in[15] + ch0 + 4);
      cb[0] = a[0]; cb[1] = a[1]; cb[2] = a[2]; cb[3] = a[3]; cb[4] = b[0]; cb[5] = b[1]; cb[6] = b[2]; cb[7] = b[3]; }
#define UNPK(dst, WW) do { dst[0] = bf_lo((WW)[0]); dst[1] = bf_hi((WW)[0]); dst[2] = bf_lo((WW)[1]); dst[3] = bf_hi((WW)[1]); dst[4] = bf_lo((WW)[2]); dst[5] = bf_hi((WW)[2]); dst[6] = bf_lo((WW)[3]); dst[7] = bf_hi((WW)[3]); } while (0)
    v4u xr[11];
#pragma unroll
    for (int j = 0; j < 3; ++j) { const int t = tbase - 3 + j; xr[j] = (v4u){0u, 0u, 0u, 0u}; if (t >= 0) xr[j] = *(const v4u*)(xb + (size_t)t * NIN); }
    const int c = tbase >> 7;
#pragma unroll
    for (int j = 0; j < 8; ++j) xr[3 + j] = *(const v4u*)(xb + (size_t)(tbase + j) * NIN);
#pragma unroll 1
    for (int sb = 0; sb < CONV_TOK / 8; ++sb) {
        const int t0 = tbase + 8 * sb, sl = t0 & 127;
        v4u xn[8];
        const int tn = (sb < CONV_TOK / 8 - 1) ? t0 + 8 : t0;
#pragma unroll
        for (int j = 0; j < 8; ++j) xn[j] = *(const v4u*)(xb + (size_t)(tn + j) * NIN);
        if (t0 == TP - 8) {
#pragma unroll
            for (int j = 0; j < 3; ++j) { float x[8]; UNPK(x, xr[8 + j]); float* o = p.out + O_CVP + (size_t)j * CONVD + ch0;
                *(f32x4*)o = (f32x4){x[0], x[1], x[2], x[3]}; *(f32x4*)(o + 4) = (f32x4){x[4], x[5], x[6], x[7]}; }
        }
        unsigned wt[8][4];
        v4u wr[8];
        float prev[8];
#pragma unroll
        for (int j = 0; j < 8; ++j) {
            float x0[8], x1[8], x2[8], x3[8], y[8];
            UNPK(x0, xr[j]); UNPK(x1, xr[j + 1]); UNPK(x2, xr[j + 2]); UNPK(x3, xr[j + 3]);
#pragma unroll
            for (int e = 0; e < 8; ++e) { const float a = cb[e] + (x0[e] * cw[0][e] + x1[e] * cw[1][e]) + (x2[e] * cw[2][e] + x3[e] * cw[3][e]); y[e] = siluf_(a); }
            wr[j].x = pk2(y[0], y[1]); wr[j].y = pk2(y[2], y[3]); wr[j].z = pk2(y[4], y[5]); wr[j].w = pk2(y[6], y[7]);
            if ((j & 1) == 0) {
#pragma unroll
                for (int e = 0; e < 8; ++e) prev[e] = y[e];
            } else {
#pragma unroll
                for (int e = 0; e < 8; ++e) wt[e][j >> 1] = pk2(prev[e], y[e]);
            }
        }
        const int h8 = (sl >> 3) & 1;
        if (ch0 < DI + 1024) {
            LAS unsigned char* tp = stg + (lane >> 2) * 1024 + (8 * (lane & 3)) * 16 + 8 * h8;
#pragma unroll
            for (int e = 0; e < 8; ++e) { *(LAS v2u*)(tp + e * 16) = (v2u){wt[e][0], wt[e][1]}; *(LAS v2u*)(tp + (e + 32) * 16) = (v2u){wt[e][2], wt[e][3]}; }
        }
        if (ch0 >= DI && ch0 < DI + 1024) {
            const int nn = ch0 - DI, g_ = nn >> 7, nl = nn & 127;
            bf16* br = (bf16*)(ws + WS_BROW) + ((((size_t)(c * 8 + g_) * 4 + (sl >> 5)) * 8 + (nl >> 4)) * 64 + (sl & 31) + 32 * ((nl >> 3) & 1)) * 8;
#pragma unroll
            for (int j = 0; j < 8; ++j) *(v4u*)(br + (size_t)j * 8) = wr[j];
        } else if (ch0 >= DI + 1024) {
            const int nn = ch0 - DI - 1024, g_ = nn >> 7, nl = nn & 127;
            bf16* cr = (bf16*)(ws + WS_CROW) + ((((size_t)(c * 8 + g_) * 4 + (sl >> 5)) * 8 + (nl >> 4)) * 64 + (sl & 31) + 32 * ((nl >> 3) & 1)) * 8;
#pragma unroll
            for (int j = 0; j < 8; ++j) *(v4u*)(cr + (size_t)j * 8) = wr[j];
        }
        xr[0] = xr[8]; xr[1] = xr[9]; xr[2] = xr[10];
#pragma unroll
        for (int j = 0; j < 8; ++j) xr[3 + j] = xn[j];
    }
    if (ch0 < DI + 1024) {
        LDS_WAIT();
        const int sg = (tbase & 127) >> 4;
        bf16* dst = (slab < 8) ? (bf16*)(ws + WS_XT) + ((size_t)(c * 128 + slab * 16) * 8 + sg) * 512 : (bf16*)(ws + WS_BT) + ((size_t)(c * 32 + (slab - 8) * 16) * 8 + sg) * 512;
#pragma unroll
        for (int T = 0; T < 16; ++T) *(v4u*)(dst + (size_t)T * 8 * 512 + lane * 8) = *(const LAS v4u*)(stg + T * 1024 + lane * 16);
        LDS_WAIT();
    }
#undef UNPK
}
__device__ __forceinline__ void conv_unit_sample(const Params& p, int unit, int lane) {
    unsigned char* ws = p.ws;
    const int b = unit / 12, slab = unit - b * 12, ch0 = slab * 512 + 8 * lane;
    v4u xr[7];
#pragma unroll
    for (int j = 0; j < 3; ++j) { const float* s = p.in[5] + ((size_t)b * 3 + j) * CONVD + ch0; const f32x4 a = *(const f32x4*)s, c = *(const f32x4*)(s + 4);
        xr[j].x = pk2(a[0], a[1]); xr[j].y = pk2(a[2], a[3]); xr[j].z = pk2(c[0], c[1]); xr[j].w = pk2(c[2], c[3]); }
    const bf16* xb = (const bf16*)(ws + WS_PROJ) + (size_t)(TP + 4 * b) * NIN + C_XBC + ch0;
#pragma unroll
    for (int j = 0; j < 4; ++j) xr[3 + j] = *(const v4u*)(xb + (size_t)j * NIN);
    float cw[4][8], cb[8];
#pragma unroll
    for (int i = 0; i < 4; ++i) { const f32x4 a = *(const f32x4*)(p.in[14] + (size_t)i * CONVD + ch0), c = *(const f32x4*)(p.in[14] + (size_t)i * CONVD + ch0 + 4);
        cw[i][0] = a[0]; cw[i][1] = a[1]; cw[i][2] = a[2]; cw[i][3] = a[3]; cw[i][4] = c[0]; cw[i][5] = c[1]; cw[i][6] = c[2]; cw[i][7] = c[3]; }
    { const f32x4 a = *(const f32x4*)(p.in[15] + ch0), c = *(const f32x4*)(p.in[15] + ch0 + 4);
      cb[0] = a[0]; cb[1] = a[1]; cb[2] = a[2]; cb[3] = a[3]; cb[4] = c[0]; cb[5] = c[1]; cb[6] = c[2]; cb[7] = c[3]; }
#define UNPK(dst, WW) do { dst[0] = bf_lo((WW)[0]); dst[1] = bf_hi((WW)[0]); dst[2] = bf_lo((WW)[1]); dst[3] = bf_hi((WW)[1]); dst[4] = bf_lo((WW)[2]); dst[5] = bf_hi((WW)[2]); dst[6] = bf_lo((WW)[3]); dst[7] = bf_hi((WW)[3]); } while (0)
#pragma unroll
    for (int j = 0; j < 3; ++j) { float x[8]; UNPK(x, xr[4 + j]); float* o = p.out + O_CVS + ((size_t)b * 3 + j) * CONVD + ch0;
        *(f32x4*)o = (f32x4){x[0], x[1], x[2], x[3]}; *(f32x4*)(o + 4) = (f32x4){x[4], x[5], x[6], x[7]}; }
    bf16* xo = (bf16*)(ws + WS_XBS) + (size_t)(4 * b) * CONVD + ch0;
#pragma unroll
    for (int j = 0; j < 4; ++j) { float x0[8], x1[8], x2[8], x3[8], y[8];
        UNPK(x0, xr[j]); UNPK(x1, xr[j + 1]); UNPK(x2, xr[j + 2]); UNPK(x3, xr[j + 3]);
#pragma unroll
        for (int e = 0; e < 8; ++e) { const float a = cb[e] + (x0[e] * cw[0][e] + x1[e] * cw[1][e]) + (x2[e] * cw[2][e] + x3[e] * cw[3][e]); y[e] = siluf_(a); }
        v4u w; w.x = pk2(y[0], y[1]); w.y = pk2(y[2], y[3]); w.z = pk2(y[4], y[5]); w.w = pk2(y[6], y[7]); *(v4u*)(xo + (size_t)j * CONVD) = w; }
#undef UNPK
}

__device__ __forceinline__ unsigned fkey(float f) { const unsigned u = __float_as_uint(f); return (u & 0x80000000u) ? ~u : (u | 0x80000000u); }
#define MFMA32(a, b, c) __builtin_amdgcn_mfma_f32_32x32x16_bf16((a), (b), (c), 0, 0, 0)
#define MFMA16(a, b, c) __builtin_amdgcn_mfma_f32_16x16x32_bf16((a), (b), (c), 0, 0, 0)
__device__ __forceinline__ float relu1(float x) { return __int_as_float(max(__float_as_int(x), 0)); }
__device__ __forceinline__ float wrelu16(const f32x16& acc, const f32x4 (&w)[4]) {
    f32x2 s0 = (f32x2){0.f, 0.f}, s1 = (f32x2){0.f, 0.f};
#pragma unroll
    for (int q = 0; q < 4; ++q) {
        const f32x2 r0 = (f32x2){relu1(acc[4 * q]), relu1(acc[4 * q + 1])}, r1 = (f32x2){relu1(acc[4 * q + 2]), relu1(acc[4 * q + 3])};
        s0 = (f32x2){w[q][0], w[q][1]} * r0 + s0; s1 = (f32x2){w[q][2], w[q][3]} * r1 + s1;
    }
    return (s0[0] + s0[1]) + (s1[0] + s1[1]);
}
__device__ __forceinline__ unsigned ik_off(unsigned row, unsigned pc) { return row * 128u + ((pc ^ (row & 7u)) << 4); }
__device__ __forceinline__ void score_unit_prompt(const Params& p, int unit, LAS unsigned char* kl  , int wave, int lane) {
    unsigned char* ws = p.ws;
    int j = 0; while (8 * (j + 1) * (j + 2) <= unit) ++j;
    const int v = unit - 8 * j * (j + 1), qb = 16 * j + v / (j + 1), kc = v % (j + 1);
    const int tw = 32 * qb + 4 * wave, r = lane & 31, hh = lane >> 5;
    const bf16* iqb = (const bf16*)(ws + WS_IQB);
    const float* iw = (const float*)(ws + WS_IWB);
    const bf16* ikb = (const bf16*)(ws + WS_IKB);
    int nkb = (32 * qb + 31 - 512 * kc) / 32 + 1; if (nkb > 16) nkb = 16;
    {
        const int tid = wave * 64 + lane, row0 = tid >> 3, pc = tid & 7;
        for (int rr = row0; rr < 32 * nkb; rr += 64) *(LAS v4u*)(kl + ik_off((unsigned)rr, (unsigned)pc)) = *(const v4u*)(ikb + (size_t)(512 * kc + rr) * 64 + 8 * pc);
    }
    bf16x8 af[2][4]; f32x4 wv[2][4];
#pragma unroll
    for (int rt = 0; rt < 2; ++rt) {
        const int tok = tw + 2 * rt + ((r >> 2) & 1), head = (r & 3) + 4 * (r >> 3);
#pragma unroll
        for (int kk = 0; kk < 4; ++kk) af[rt][kk] = *(const bf16x8*)(iqb + (size_t)tok * 1024 + head * 64 + 16 * kk + 8 * hh);
#pragma unroll
        for (int q = 0; q < 4; ++q) wv[rt][q] = *(const f32x4*)(iw + (size_t)(tw + 2 * rt + hh) * 16 + 4 * q);
    }
    LDS_WAIT();
    __syncthreads();
    unsigned* sc = (unsigned*)(ws + WS_SC);
    int nkt = (tw + 3 - 512 * kc) / 32 + 1; if (nkt > 16) nkt = 16;
#pragma unroll 2
    for (int kt = 0; kt < nkt; ++kt) {
        const int s0 = 512 * kc + 32 * kt;
        bf16x8 bf_[4];
#pragma unroll
        for (int kk = 0; kk < 4; ++kk) bf_[kk] = *(const LAS bf16x8*)(kl + ik_off((unsigned)(32 * kt + r), (unsigned)(2 * kk + hh)));
#pragma unroll
        for (int rt = 0; rt < 2; ++rt) {
            f32x16 acc;
#pragma unroll
            for (int i = 0; i < 16; ++i) acc[i] = 0.f;
#pragma unroll
            for (int kk = 0; kk < 4; ++kk) acc = MFMA32(af[rt][kk], bf_[kk], acc);
            const float s_ = wrelu16(acc, wv[rt]);
            sc[(size_t)(tw + 2 * rt + hh) * TP + s0 + r] = fkey(s_);
        }
    }
    __syncthreads();
}
__device__ __forceinline__ void score_job_sample(const Params& p, int job, int lane) {
    unsigned char* ws = p.ws;
    const int b = job / 13, ktg = job - b * 13, r = lane & 31, hh = lane >> 5;
    const bf16* proj = (const bf16*)(ws + WS_IQB);
    const float* iw = (const float*)(ws + WS_IWB);
    bf16x8 af[2][4]; f32x4 wv[2][4];
#pragma unroll
    for (int rt = 0; rt < 2; ++rt) {
        const int tok = TP + 4 * b + 2 * rt + ((r >> 2) & 1), head = (r & 3) + 4 * (r >> 3);
#pragma unroll
        for (int kk = 0; kk < 4; ++kk) af[rt][kk] = *(const bf16x8*)(proj + (size_t)tok * 1024 + head * 64 + 16 * kk + 8 * hh);
#pragma unroll
        for (int q = 0; q < 4; ++q) wv[rt][q] = *(const f32x4*)(iw + (size_t)(TP + 4 * b + 2 * rt + hh) * 16 + 4 * q);
    }
    const bf16* ikb = (const bf16*)(ws + WS_IKB);
    const int* pt = (const int*)p.in[7] + b * 16;
    unsigned* sc = (unsigned*)(ws + WS_SCS);
    f32x4 raw[8];
#define SCS_RAW(KT_) { const int key_ = 32 * (KT_) + r; const float* src_ = p.in[4] + ((size_t)pt[key_ >> 7] * 128 + (key_ & 127)) * 64 + 8 * hh; \
        _Pragma("unroll") for (int kk = 0; kk < 4; ++kk) { raw[2 * kk] = *(const f32x4*)(src_ + 16 * kk); raw[2 * kk + 1] = *(const f32x4*)(src_ + 16 * kk + 4); } }
    if (5 * ktg < 64) SCS_RAW(5 * ktg);
    for (int kt = 5 * ktg; kt < 5 * ktg + 5; ++kt) {
        const int key = 32 * kt + r;
        bf16x8 bfr[4];
        if (kt < 64) {
#pragma unroll
            for (int kk = 0; kk < 4; ++kk) { const f32x4 a = raw[2 * kk], c = raw[2 * kk + 1];
                v4u w; w.x = pk2(a[0], a[1]); w.y = pk2(a[2], a[3]); w.z = pk2(c[0], c[1]); w.w = pk2(c[2], c[3]); bfr[kk] = __builtin_bit_cast(bf16x8, w); }
            if (kt + 1 < 5 * ktg + 5 && kt + 1 < 64) SCS_RAW(kt + 1);
        } else if (key < NKS) {
#pragma unroll
            for (int kk = 0; kk < 4; ++kk) bfr[kk] = *(const bf16x8*)(ikb + (size_t)(TP + 4 * b + key - PAST) * 64 + 16 * kk + 8 * hh);
        } else {
#pragma unroll
            for (int kk = 0; kk < 4; ++kk) bfr[kk] = (bf16x8){0, 0, 0, 0, 0, 0, 0, 0};
        }
#pragma unroll
        for (int rt = 0; rt < 2; ++rt) {
            f32x16 acc;
#pragma unroll
            for (int i = 0; i < 16; ++i) acc[i] = 0.f;
#pragma unroll
            for (int kk = 0; kk < 4; ++kk) acc = MFMA32(af[rt][kk], bfr[kk], acc);
            const float s = wrelu16(acc, wv[rt]);
            if (key < NKS) sc[(size_t)(4 * b + 2 * rt + hh) * SCS_LD + key] = fkey(s);
        }
    }
}

template <bool SAMPLE>
__device__ __forceinline__ int sel_resolve(const int* pt, int b, int j) { if (!SAMPLE) return j; return j < PAST ? pt[j >> 7] * 128 + (j & 127) : (0x40000000 | (4 * b + j - PAST)); }
template <bool SAMPLE>
__device__ __forceinline__ void select_row_slow(const Params& p, int row, LAS unsigned* hist, int lane) {
    unsigned char* ws = p.ws;
    const int n = SAMPLE ? (PAST + 1 + ((row - TP) & 3)) : (row + 1);
    const int b = SAMPLE ? ((row - TP) >> 2) : 0;
    const unsigned* keys = SAMPLE ? (const unsigned*)(ws + WS_SCS) + (size_t)(row - TP) * SCS_LD : (const unsigned*)(ws + WS_SC) + (size_t)row * TP;
    const int* pt = (const int*)p.in[7] + b * 16;
    int* sel = (int*)(ws + WS_SEL) + (size_t)row * 256;
    int* cnt = (int*)(ws + WS_CNT) + row;
    if (n <= 256) {
        for (int i = 0; i < 4; ++i) { const int j = i * 64 + lane; sel[j] = sel_resolve<SAMPLE>(pt, b, j < n ? j : 0); }
        if (lane == 0) *cnt = n;
        return;
    }
    const int nch = (n + 63) >> 6;
    unsigned prefix = 0u, pmask = 0u; int need = 256;
    for (int level = 0; level < 4; ++level) {
        const int shift = level == 0 ? 22 : (level == 1 ? 12 : (level == 2 ? 2 : 0));
        const unsigned dm = level < 3 ? 1023u : 3u;
#pragma unroll
        for (int q = 0; q < 16; ++q) hist[q * 64 + lane] = 0u;
        LDS_WAIT();
#pragma unroll 4
        for (int i = 0; i < nch; ++i) { const int j = i * 64 + lane;
            if (j < n) { const unsigned k = keys[j];
                if ((k & pmask) == prefix) __hip_atomic_fetch_add(hist + ((k >> shift) & dm), 1u, __ATOMIC_RELAXED, __HIP_MEMORY_SCOPE_WORKGROUP); } }
        LDS_WAIT();
        unsigned h[16]; unsigned s = 0u;
#pragma unroll
        for (int q = 0; q < 16; ++q) { h[q] = hist[16 * lane + q]; s += h[q]; }
        unsigned S = s;
#pragma unroll
        for (int o = 1; o < 64; o <<= 1) { const unsigned t = __shfl_down(S, o); if (lane + o < 64) S += t; }
        const unsigned long long bal = __ballot(S >= (unsigned)need);
        const int L = 63 - __builtin_clzll(bal);
        unsigned cabove = S - s;
        int dsel = 0; unsigned csel = 0u; bool found = false;
#pragma unroll
        for (int q = 15; q >= 0; --q) { if (!found) { if (cabove + h[q] >= (unsigned)need) { dsel = 16 * lane + q; csel = cabove; found = true; } else cabove += h[q]; } }
        const int d = __shfl(dsel, L); const unsigned ca = __shfl(csel, L);
        need -= (int)ca; prefix |= ((unsigned)d) << shift; pmask |= dm << shift;
        LDS_WAIT();
    }
    const unsigned T = prefix;
    int pos = 0, eqtaken = 0;
    const unsigned long long lt = (1ull << lane) - 1ull;
#pragma unroll 2
    for (int i = 0; i < nch; ++i) {
        const int j = i * 64 + lane; const bool valid = j < n;
        const unsigned k = valid ? keys[j] : 0u;
        const bool gt = valid && k > T, eq = valid && k == T;
        const unsigned long long me = __ballot(eq);
        const bool esel = eq && (eqtaken + __popcll(me & lt) < need);
        const bool s_ = gt || esel;
        const unsigned long long ms = __ballot(s_);
        if (s_) sel[pos + __popcll(ms & lt)] = sel_resolve<SAMPLE>(pt, b, j);
        pos += __popcll(ms); eqtaken += __popcll(me);
    }
    if (lane == 0) *cnt = 256;
}

__device__ __forceinline__ int pfx(unsigned long long m) { return (int)__builtin_amdgcn_mbcnt_hi((unsigned)(m >> 32), __builtin_amdgcn_mbcnt_lo((unsigned)m, 0u)); }
__device__ __forceinline__ void find_digit(const LAS unsigned* hist, int need, int lane, int& d, unsigned& ca) {
    unsigned h[16]; unsigned s = 0u;
#pragma unroll
    for (int q = 0; q < 4; ++q) { const v4u t = *(const LAS v4u*)(hist + 16 * lane + 4 * q); h[4 * q] = t.x; h[4 * q + 1] = t.y; h[4 * q + 2] = t.z; h[4 * q + 3] = t.w; s += (t.x + t.y) + (t.z + t.w); }
    int P = (int)s;
    P += __builtin_amdgcn_update_dpp(0, P, 0x111, 0xf, 0xf, false); P += __builtin_amdgcn_update_dpp(0, P, 0x112, 0xf, 0xf, false);
    P += __builtin_amdgcn_update_dpp(0, P, 0x114, 0xf, 0xf, false); P += __builtin_amdgcn_update_dpp(0, P, 0x118, 0xf, 0xf, false);
    P += __builtin_amdgcn_update_dpp(0, P, 0x142, 0xa, 0xf, false); P += __builtin_amdgcn_update_dpp(0, P, 0x143, 0xc, 0xf, false);
    const unsigned S = (unsigned)__builtin_amdgcn_readlane(P, 63) - (unsigned)P + s;
    const unsigned long long bal = __ballot(S >= (unsigned)need);
    const int L = 63 - __builtin_clzll(bal);
    unsigned cabove = S - s; int dsel = 0; unsigned csel = 0u; bool found = false;
#pragma unroll
    for (int q = 15; q >= 0; --q) { if (!found) { if (cabove + h[q] >= (unsigned)need) { dsel = 16 * lane + q; csel = cabove; found = true; } else cabove += h[q]; } }
    d = __builtin_amdgcn_readlane(dsel, L); ca = (unsigned)__builtin_amdgcn_readlane((int)csel, L);
}
constexpr int CAND_CAP = 2048;
template <bool SAMPLE>
__device__ __forceinline__ void select_row(const Params& p, int row, LAS unsigned* hist, LAS unsigned* ck  , LAS unsigned short* ci  , int lane) {
    unsigned char* ws = p.ws;
    const int n = SAMPLE ? (PAST + 1 + ((row - TP) & 3)) : (row + 1);
    const int b = SAMPLE ? ((row - TP) >> 2) : 0;
    const unsigned* keys = SAMPLE ? (const unsigned*)(ws + WS_SCS) + (size_t)(row - TP) * SCS_LD : (const unsigned*)(ws + WS_SC) + (size_t)row * TP;
    const int* pt = (const int*)p.in[7] + b * 16;
    int* sel = (int*)(ws + WS_SEL) + (size_t)row * 256;
    int* cnt = (int*)(ws + WS_CNT) + row;
    if (n <= 256) {
        for (int i = 0; i < 4; ++i) { const int j = i * 64 + lane; sel[j] = sel_resolve<SAMPLE>(pt, b, j < n ? j : 0); }
        if (lane == 0) *cnt = n;
        return;
    }
    constexpr int NH = SAMPLE ? 3 : 8;
    const int nit = (n + 255) >> 8;
    const int nbatch = (nit + NH - 1) / NH;
    v4u kv[NH], nx[NH];
#pragma unroll
    for (int i = 0; i < NH; ++i) { kv[i] = (v4u){0u, 0u, 0u, 0u}; if (i < nit) kv[i] = *(const v4u*)(keys + 4 * (i * 64 + lane)); }
#pragma unroll
    for (int i = 0; i < NH; ++i) { nx[i] = (v4u){0u, 0u, 0u, 0u}; if (NH + i < nit) nx[i] = *(const v4u*)(keys + 4 * ((NH + i) * 64 + lane)); }
    unsigned L = 0u;
    if (n > 512) {
        const int ns = min((n + 1) >> 1, NH * 128);
        const float t = 256.f * (float)ns / (float)n;
        const int r = (int)(t + 4.5f * __builtin_sqrtf(t)) + 2;
#pragma unroll
        for (int q = 0; q < 4; ++q) *(LAS v4u*)(hist + 4 * (q * 64 + lane)) = (v4u){0u, 0u, 0u, 0u};
        LDS_WAIT();
#pragma unroll
        for (int i = 0; i < NH; ++i) { const int j0 = 4 * (i * 64 + lane);
            if (j0 < n) __hip_atomic_fetch_add(hist + (kv[i].x >> 22), 1u, __ATOMIC_RELAXED, __HIP_MEMORY_SCOPE_WORKGROUP);
            if (j0 + 2 < n) __hip_atomic_fetch_add(hist + (kv[i].z >> 22), 1u, __ATOMIC_RELAXED, __HIP_MEMORY_SCOPE_WORKGROUP); }
        LDS_WAIT();
        int da; unsigned caa; find_digit(hist, r, lane, da, caa);
        LDS_WAIT();
#pragma unroll
        for (int q = 0; q < 4; ++q) *(LAS v4u*)(hist + 4 * (q * 64 + lane)) = (v4u){0u, 0u, 0u, 0u};
        LDS_WAIT();
#pragma unroll
        for (int i = 0; i < NH; ++i) { const int j0 = 4 * (i * 64 + lane);
            if (j0 < n && (int)(kv[i].x >> 22) == da) __hip_atomic_fetch_add(hist + ((kv[i].x >> 12) & 1023u), 1u, __ATOMIC_RELAXED, __HIP_MEMORY_SCOPE_WORKGROUP);
            if (j0 + 2 < n && (int)(kv[i].z >> 22) == da) __hip_atomic_fetch_add(hist + ((kv[i].z >> 12) & 1023u), 1u, __ATOMIC_RELAXED, __HIP_MEMORY_SCOPE_WORKGROUP); }
        LDS_WAIT();
        int db; unsigned cab; find_digit(hist, r - (int)caa, lane, db, cab);
        L = ((unsigned)da << 22) | ((unsigned)db << 12);
        LDS_WAIT();
    }
    if (L == 0u) L = 1u;
    int m = 0;
#pragma unroll 1
    for (int hb = 0; hb < nbatch; ++hb) {
        if (256 * (hb * NH + NH) > n) {
#pragma unroll
            for (int i = 0; i < NH; ++i) { const int j0 = 4 * ((hb * NH + i) * 64 + lane);
#pragma unroll
                for (int c = 0; c < 4; ++c) kv[i][c] = (j0 + c < n) ? kv[i][c] : 0u; }
        }
#pragma unroll
        for (int i = 0; i < NH; ++i) { const int j0 = 4 * ((hb * NH + i) * 64 + lane); const v4u v = kv[i];
            bool e[4]; unsigned long long me[4]; int be = 0;
#pragma unroll
            for (int c = 0; c < 4; ++c) { e[c] = v[c] >= L; me[c] = __ballot(e[c]); be += pfx(me[c]); }
            unsigned oe = (unsigned)(m + be);
#pragma unroll
            for (int c = 0; c < 4; ++c) { const unsigned slot = min(e[c] ? oe : 0x7fffffffu, (unsigned)(CAND_CAP + lane));
                ck[slot] = v[c]; ci[slot] = (unsigned short)(j0 + c); oe += e[c] ? 1u : 0u; m += __popcll(me[c]); }
        }
#pragma unroll
        for (int i = 0; i < NH; ++i) kv[i] = nx[i];
        if (hb + 2 < nbatch) {
#pragma unroll
            for (int i = 0; i < NH; ++i) { nx[i] = (v4u){0u, 0u, 0u, 0u}; if ((hb + 2) * NH + i < nit) nx[i] = *(const v4u*)(keys + 4 * (((hb + 2) * NH + i) * 64 + lane)); }
        }
    }
    if (m < 256 || m > CAND_CAP) { select_row_slow<SAMPLE>(p, row, hist, lane); return; }
    LDS_WAIT();
    unsigned prefix = 0u, pmask = 0u; int need = 256;
    const int mq = (m + 63) >> 6;
#pragma unroll
    for (int level = 0; level < 4; ++level) {
        const int shift = level == 0 ? 22 : (level == 1 ? 12 : (level == 2 ? 2 : 0));
        const unsigned dm = level < 3 ? 1023u : 3u;
#pragma unroll
        for (int q = 0; q < 4; ++q) *(LAS v4u*)(hist + 4 * (q * 64 + lane)) = (v4u){0u, 0u, 0u, 0u};
        LDS_WAIT();
        for (int q = 0; q < mq; ++q) { const int e_ = q * 64 + lane;
            if (e_ < m) { const unsigned k = ck[e_]; if ((k & pmask) == prefix) __hip_atomic_fetch_add(hist + ((k >> shift) & dm), 1u, __ATOMIC_RELAXED, __HIP_MEMORY_SCOPE_WORKGROUP); } }
        LDS_WAIT();
        int d; unsigned ca; find_digit(hist, need, lane, d, ca);
        need -= (int)ca; prefix |= ((unsigned)d) << shift; pmask |= dm << shift;
        LDS_WAIT();
    }
    const unsigned T = prefix;
    int pos = 0, eqtaken = 0;
    for (int q = 0; q < mq; ++q) { const int e_ = q * 64 + lane; const bool valid = e_ < m;
        const unsigned k = valid ? ck[e_] : 0u;
        const bool gt = valid && k > T, eq = valid && k == T;
        const unsigned long long me = __ballot(eq);
        const bool esel = eq && (eqtaken + pfx(me) < need);
        const bool s_ = gt || esel;
        const unsigned long long ms = __ballot(s_);
        if (s_) sel[pos + pfx(ms)] = sel_resolve<SAMPLE>(pt, b, (int)ci[e_]);
        pos += __popcll(ms); eqtaken += __popcll(me); }
    if (lane == 0) *cnt = 256;
    LDS_WAIT();
}

typedef unsigned pl2_t __attribute__((ext_vector_type(2)));
__device__ __forceinline__ float rows4_sum(float x) {
    auto a = __builtin_amdgcn_permlane16_swap(__float_as_uint(x), __float_as_uint(x), false, false); x = __uint_as_float(a[0]) + __uint_as_float(a[1]);
    auto b = __builtin_amdgcn_permlane32_swap(__float_as_uint(x), __float_as_uint(x), false, false); return __uint_as_float(b[0]) + __uint_as_float(b[1]);
}
__device__ __forceinline__ float rows4_max(float x) {
    auto a = __builtin_amdgcn_permlane16_swap(__float_as_uint(x), __float_as_uint(x), false, false); x = fmaxf(__uint_as_float(a[0]), __uint_as_float(a[1]));
    auto b = __builtin_amdgcn_permlane32_swap(__float_as_uint(x), __float_as_uint(x), false, false); return fmaxf(__uint_as_float(b[0]), __uint_as_float(b[1]));
}
__device__ __forceinline__ unsigned vt_off(unsigned row, unsigned ch) { return 256u * row + 16u * (ch ^ (((row & 3) << 2) | ((row >> 2) & 3))); }
template <bool SAMPLE>
__device__ __forceinline__ void attn_job(const Params& p, int row, int g, LAS unsigned char* vt, int lane) {
    unsigned char* ws = p.ws;
    LAS int* sel = (LAS int*)(vt + 8192);
    *(LAS v4u*)(sel + 4 * lane) = *(const v4u*)((const int*)(ws + WS_SEL) + (size_t)row * 256 + 4 * lane);
    const int cnt = ((const int*)(ws + WS_CNT))[row];
    LDS_WAIT();
    const int hd = lane & 15, kq = lane >> 4;
    const bf16* kbp = (const bf16*)(ws + WS_KB); const bf16* vbp = (const bf16*)(ws + WS_VB);
    const float* ck = p.in[2]; const float* cv = p.in[3]; const float* nk = p.out + O_KS; const float* nv = p.out + O_VS;
    bf16x8 qf[4];
#pragma unroll
    for (int kk = 0; kk < 4; ++kk) {
        qf[kk] = (bf16x8){0, 0, 0, 0, 0, 0, 0, 0};
        if (hd < 4) qf[kk] = *(const bf16x8*)((const bf16*)(ws + WS_QB) + (size_t)row * DM + (4 * g + hd) * 128 + 32 * kk + 8 * kq);
    }
    const float sl2 = 0.08838834764831845f * 1.4426950408889634f;
    float m_run = -1e30f, l_run = 0.f;
    f32x4 o[8];
#pragma unroll
    for (int c = 0; c < 8; ++c) o[c] = (f32x4){0.f, 0.f, 0.f, 0.f};
    for (int ch = 0; ch < 8; ++ch) {
        if (32 * ch >= cnt) break;
        const int ea = sel[32 * ch + hd], eb = sel[32 * ch + 16 + hd];
        bf16x8 ka[4], kb[4];
        if (!SAMPLE) {
            const bf16* pa = kbp + (size_t)ea * 512 + g * 128 + 8 * kq; const bf16* pb = kbp + (size_t)eb * 512 + g * 128 + 8 * kq;
#pragma unroll
            for (int kk = 0; kk < 4; ++kk) { ka[kk] = *(const bf16x8*)(pa + 32 * kk); kb[kk] = *(const bf16x8*)(pb + 32 * kk); }
        } else {
            const float* pa = ((ea & 0x40000000) ? nk + (size_t)(ea & 0xffff) * 512 : ck + (size_t)ea * 512) + g * 128 + 8 * kq;
            const float* pb = ((eb & 0x40000000) ? nk + (size_t)(eb & 0xffff) * 512 : ck + (size_t)eb * 512) + g * 128 + 8 * kq;
#pragma unroll
            for (int kk = 0; kk < 4; ++kk) {
                const f32x4 a0 = *(const f32x4*)(pa + 32 * kk), a1 = *(const f32x4*)(pa + 32 * kk + 4), b0 = *(const f32x4*)(pb + 32 * kk), b1 = *(const f32x4*)(pb + 32 * kk + 4);
                v4u wa, wb; wa.x = pk2(a0[0], a0[1]); wa.y = pk2(a0[2], a0[3]); wa.z = pk2(a1[0], a1[1]); wa.w = pk2(a1[2], a1[3]);
                wb.x = pk2(b0[0], b0[1]); wb.y = pk2(b0[2], b0[3]); wb.z = pk2(b1[0], b1[1]); wb.w = pk2(b1[2], b1[3]);
                ka[kk] = __builtin_bit_cast(bf16x8, wa); kb[kk] = __builtin_bit_cast(bf16x8, wb); }
        }
        {
            const int c16 = lane & 15, rs = lane >> 4;
#pragma unroll
            for (int i = 0; i < 8; ++i) { const int slot = rs + 4 * i; const int e = sel[32 * ch + slot];
                v4u w;
                if (!SAMPLE) w = *(const v4u*)(vbp + (size_t)e * 512 + g * 128 + 8 * c16);
                else { const float* pv = ((e & 0x40000000) ? nv + (size_t)(e & 0xffff) * 512 : cv + (size_t)e * 512) + g * 128 + 8 * c16;
                    const f32x4 a0 = *(const f32x4*)pv, a1 = *(const f32x4*)(pv + 4); w.x = pk2(a0[0], a0[1]); w.y = pk2(a0[2], a0[3]); w.z = pk2(a1[0], a1[1]); w.w = pk2(a1[2], a1[3]); }
                *(LAS v4u*)(vt + vt_off(slot, c16)) = w; }
        }
        f32x4 sa = (f32x4){0.f, 0.f, 0.f, 0.f}, sb = (f32x4){0.f, 0.f, 0.f, 0.f};
#pragma unroll
        for (int kk = 0; kk < 4; ++kk) { sa = MFMA16(ka[kk], qf[kk], sa); sb = MFMA16(kb[kk], qf[kk], sb); }
        float mx = -1e30f;
#pragma unroll
        for (int i = 0; i < 4; ++i) {
            sa[i] = (32 * ch + 4 * kq + i < cnt) ? sa[i] * sl2 : -1e30f; sb[i] = (32 * ch + 16 + 4 * kq + i < cnt) ? sb[i] * sl2 : -1e30f;
            mx = fmaxf(mx, fmaxf(sa[i], sb[i])); }
        mx = rows4_max(mx);
        const float m_new = fmaxf(m_run, mx), alpha = exp2f(m_run - m_new);
        float ps = 0.f; float pa_[4], pb_[4];
#pragma unroll
        for (int i = 0; i < 4; ++i) { pa_[i] = exp2f(sa[i] - m_new); pb_[i] = exp2f(sb[i] - m_new); ps += pa_[i] + pb_[i]; }
        ps = rows4_sum(ps);
        l_run = l_run * alpha + ps; m_run = m_new;
        v4u pw; pw.x = pk2(pa_[0], pa_[1]); pw.y = pk2(pa_[2], pa_[3]); pw.z = pk2(pb_[0], pb_[1]); pw.w = pk2(pb_[2], pb_[3]);
        const bf16x8 pf = __builtin_bit_cast(bf16x8, pw);
        const float al0 = __int_as_float(__builtin_amdgcn_readlane(__float_as_int(alpha), 0)), al1 = __int_as_float(__builtin_amdgcn_readlane(__float_as_int(alpha), 1)), al2 = __int_as_float(__builtin_amdgcn_readlane(__float_as_int(alpha), 2)), al3 = __int_as_float(__builtin_amdgcn_readlane(__float_as_int(alpha), 3));
#pragma unroll
        for (int c = 0; c < 8; ++c) { o[c][0] *= al0; o[c][1] *= al1; o[c][2] *= al2; o[c][3] *= al3; }
        LDS_WAIT();
        const unsigned q4 = (unsigned)(hd >> 2), p4 = (unsigned)(lane & 3);
#pragma unroll
        for (int c = 0; c < 8; ++c) {
            const unsigned r0 = 4u * kq + q4, r1 = 16u + 4u * kq + q4, chk = 2u * c + (p4 >> 1);
            const v4i16_t lo = __builtin_amdgcn_ds_read_tr16_b64_v4i16((LAS v4i16_t*)(vt + vt_off(r0, chk) + 8u * (p4 & 1u)));
            const v4i16_t hi = __builtin_amdgcn_ds_read_tr16_b64_v4i16((LAS v4i16_t*)(vt + vt_off(r1, chk) + 8u * (p4 & 1u)));
            const bf16x8 vf = (bf16x8){lo[0], lo[1], lo[2], lo[3], hi[0], hi[1], hi[2], hi[3]};
            o[c] = MFMA16(pf, vf, o[c]);
        }
        LDS_WAIT();
    }
    const float l0 = __int_as_float(__builtin_amdgcn_readlane(__float_as_int(l_run), 0)), l1 = __int_as_float(__builtin_amdgcn_readlane(__float_as_int(l_run), 1)), l2 = __int_as_float(__builtin_amdgcn_readlane(__float_as_int(l_run), 2)), l3 = __int_as_float(__builtin_amdgcn_readlane(__float_as_int(l_run), 3));
    if (lane < 16) {
        bf16* ao = (bf16*)(ws + WS_AO) + (size_t)row * DM + (4 * g) * 128 + lane;
        const float i0 = 1.f / l0, i1 = 1.f / l1, i2 = 1.f / l2, i3 = 1.f / l3;
#pragma unroll
        for (int c = 0; c < 8; ++c) {
            ao[0 * 128 + 16 * c] = (bf16)(pk2(o[c][0] * i0, 0.f) & 0xffffu); ao[1 * 128 + 16 * c] = (bf16)(pk2(o[c][1] * i1, 0.f) & 0xffffu);
            ao[2 * 128 + 16 * c] = (bf16)(pk2(o[c][2] * i2, 0.f) & 0xffffu); ao[3 * 128 + 16 * c] = (bf16)(pk2(o[c][3] * i3, 0.f) & 0xffffu); }
    }
}

__device__ __forceinline__ bf16x8 fp8x8_to_bf16(unsigned w0, unsigned w1) {
    const f32x2 a = __builtin_amdgcn_cvt_pk_f32_fp8((int)w0, false), b = __builtin_amdgcn_cvt_pk_f32_fp8((int)w0, true);
    const f32x2 c = __builtin_amdgcn_cvt_pk_f32_fp8((int)w1, false), d = __builtin_amdgcn_cvt_pk_f32_fp8((int)w1, true);
    v4u o;
    o.x = __builtin_amdgcn_perm(__float_as_uint(a[1]), __float_as_uint(a[0]), 0x07060302u); o.y = __builtin_amdgcn_perm(__float_as_uint(b[1]), __float_as_uint(b[0]), 0x07060302u);
    o.z = __builtin_amdgcn_perm(__float_as_uint(c[1]), __float_as_uint(c[0]), 0x07060302u); o.w = __builtin_amdgcn_perm(__float_as_uint(d[1]), __float_as_uint(d[0]), 0x07060302u);
    return __builtin_bit_cast(bf16x8, o);
}
struct AttnPf { v4u k[4]; v4u v[4]; };
__device__ __forceinline__ void attn_prefetch(AttnPf& f, const unsigned char* k8, const unsigned char* v8, const LAS int* selb, int ch, int g, int lane) {
    const int hd = lane & 15, kq = lane >> 4;
    const int ea = selb[32 * ch + hd], eb = selb[32 * ch + 16 + hd];
    const unsigned char* pa = k8 + (size_t)ea * 512 + g * 128 + 32 * kq; const unsigned char* pb = k8 + (size_t)eb * 512 + g * 128 + 32 * kq;
    f.k[0] = *(const v4u*)pa; f.k[1] = *(const v4u*)(pa + 16); f.k[2] = *(const v4u*)pb; f.k[3] = *(const v4u*)(pb + 16);
#pragma unroll
    for (int i = 0; i < 4; ++i) { const int e = selb[32 * ch + (lane >> 3) + 8 * i]; f.v[i] = *(const v4u*)(v8 + (size_t)e * 512 + g * 128 + 16 * (lane & 7)); }
}
#define MFMA16F8(a, b, c) __builtin_amdgcn_mfma_f32_16x16x32_fp8_fp8((a), (b), (c), 0, 0, 0)
__device__ __forceinline__ long pk64(unsigned lo, unsigned hi) { return (long)(((unsigned long long)hi << 32) | (unsigned long long)lo); }
template <bool ONLINE>
__device__ __forceinline__ void attn_chunk(const AttnPf& f, const long (&qf)[4], int ch, int cnt, float mb, float& m_run, float& l_run, f32x4 (&o)[8], LAS unsigned char* vt, int lane) {
    const int hd = lane & 15, kq = lane >> 4;
    const float sl2 = 0.08838834764831845f * 1.4426950408889634f;
#pragma unroll
    for (int i = 0; i < 4; ++i) { const unsigned slot = (unsigned)((lane >> 3) + 8 * i), c8 = (unsigned)(lane & 7);
        *(LAS bf16x8*)(vt + vt_off(slot, 2 * c8)) = fp8x8_to_bf16(f.v[i].x, f.v[i].y); *(LAS bf16x8*)(vt + vt_off(slot, 2 * c8 + 1)) = fp8x8_to_bf16(f.v[i].z, f.v[i].w); }
    f32x4 sa = (f32x4){0.f, 0.f, 0.f, 0.f}, sb = (f32x4){0.f, 0.f, 0.f, 0.f};
    sa = MFMA16F8(pk64(f.k[0].x, f.k[0].y), qf[0], sa); sa = MFMA16F8(pk64(f.k[0].z, f.k[0].w), qf[1], sa);
    sa = MFMA16F8(pk64(f.k[1].x, f.k[1].y), qf[2], sa); sa = MFMA16F8(pk64(f.k[1].z, f.k[1].w), qf[3], sa);
    sb = MFMA16F8(pk64(f.k[2].x, f.k[2].y), qf[0], sb); sb = MFMA16F8(pk64(f.k[2].z, f.k[2].w), qf[1], sb);
    sb = MFMA16F8(pk64(f.k[3].x, f.k[3].y), qf[2], sb); sb = MFMA16F8(pk64(f.k[3].z, f.k[3].w), qf[3], sb);
    float pa_[4], pb_[4];
    if (ONLINE) {
        float mx = -1e30f;
#pragma unroll
        for (int i = 0; i < 4; ++i) {
            sa[i] = (32 * ch + 4 * kq + i < cnt) ? sa[i] * sl2 : -1e30f; sb[i] = (32 * ch + 16 + 4 * kq + i < cnt) ? sb[i] * sl2 : -1e30f;
            mx = fmaxf(mx, fmaxf(sa[i], sb[i])); }
        mx = rows4_max(mx);
        const float m_new = fmaxf(m_run, mx), alpha = exp2f(m_run - m_new);
        float ps = 0.f;
#pragma unroll
        for (int i = 0; i < 4; ++i) { pa_[i] = exp2f(sa[i] - m_new); pb_[i] = exp2f(sb[i] - m_new); ps += pa_[i] + pb_[i]; }
        ps = rows4_sum(ps);
        l_run = l_run * alpha + ps; m_run = m_new;
        const float al0 = __int_as_float(__builtin_amdgcn_readlane(__float_as_int(alpha), 0)), al1 = __int_as_float(__builtin_amdgcn_readlane(__float_as_int(alpha), 1)), al2 = __int_as_float(__builtin_amdgcn_readlane(__float_as_int(alpha), 2)), al3 = __int_as_float(__builtin_amdgcn_readlane(__float_as_int(alpha), 3));
#pragma unroll
        for (int c = 0; c < 8; ++c) { o[c][0] *= al0; o[c][1] *= al1; o[c][2] *= al2; o[c][3] *= al3; }
    } else {
        float ps = 0.f;
#pragma unroll
        for (int i = 0; i < 4; ++i) {
            pa_[i] = (32 * ch + 4 * kq + i < cnt) ? __builtin_amdgcn_exp2f(sa[i] * sl2 - mb) : 0.f; pb_[i] = (32 * ch + 16 + 4 * kq + i < cnt) ? __builtin_amdgcn_exp2f(sb[i] * sl2 - mb) : 0.f;
            ps += pa_[i] + pb_[i]; }
        l_run += ps;
    }
    v4u pw; pw.x = pk2(pa_[0], pa_[1]); pw.y = pk2(pa_[2], pa_[3]); pw.z = pk2(pb_[0], pb_[1]); pw.w = pk2(pb_[2], pb_[3]);
    const bf16x8 pf = __builtin_bit_cast(bf16x8, pw);
    LDS_WAIT();
    const unsigned q4 = (unsigned)(hd >> 2), p4 = (unsigned)(lane & 3);
#pragma unroll
    for (int c = 0; c < 8; ++c) {
        const unsigned r0 = 4u * kq + q4, r1 = 16u + 4u * kq + q4, chk = 2u * c + (p4 >> 1);
        const v4i16_t lo = __builtin_amdgcn_ds_read_tr16_b64_v4i16((LAS v4i16_t*)(vt + vt_off(r0, chk) + 8u * (p4 & 1u)));
        const v4i16_t hi = __builtin_amdgcn_ds_read_tr16_b64_v4i16((LAS v4i16_t*)(vt + vt_off(r1, chk) + 8u * (p4 & 1u)));
        const bf16x8 vf = (bf16x8){lo[0], lo[1], lo[2], lo[3], hi[0], hi[1], hi[2], hi[3]};
        o[c] = MFMA16(pf, vf, o[c]);
    }
    LDS_WAIT();
}
template <bool ONLINE>
__device__ __forceinline__ void attn_job_prompt(const Params& p, int row, int g, float mb, LAS unsigned char* vt, LAS int* selb, int lane, int cnt, v4u selv, int nrow, int& ncnt, v4u& nselv) {
    unsigned char* ws = p.ws;
    const int nch = (cnt + 31) >> 5;
    const int hd = lane & 15, kq = lane >> 4;
    *(LAS v4u*)(selb + 4 * lane) = selv;
    if (nrow >= 0) { ncnt = ((const int*)(ws + WS_CNT))[nrow]; nselv = *(const v4u*)((const int*)(ws + WS_SEL) + (size_t)nrow * 256 + 4 * lane); }
    long qf[4];
#pragma unroll
    for (int kk = 0; kk < 4; ++kk) {
        qf[kk] = 0;
        if (hd < 4) { const v4u w = *(const v4u*)((const bf16*)(ws + WS_QB) + (size_t)row * DM + (4 * g + hd) * 128 + 32 * kq + 8 * kk);
            int lo = __builtin_amdgcn_cvt_pk_fp8_f32(bf_lo(w.x), bf_hi(w.x), 0, false); lo = __builtin_amdgcn_cvt_pk_fp8_f32(bf_lo(w.y), bf_hi(w.y), lo, true);
            int hi = __builtin_amdgcn_cvt_pk_fp8_f32(bf_lo(w.z), bf_hi(w.z), 0, false); hi = __builtin_amdgcn_cvt_pk_fp8_f32(bf_lo(w.w), bf_hi(w.w), hi, true);
            qf[kk] = pk64((unsigned)lo, (unsigned)hi); }
    }
    LDS_WAIT();
    const unsigned char* k8 = ws + WS_K8; const unsigned char* v8 = ws + WS_V8;
    float m_run = -1e30f, l_run = 0.f;
    f32x4 o[8];
#pragma unroll
    for (int c = 0; c < 8; ++c) o[c] = (f32x4){0.f, 0.f, 0.f, 0.f};
    AttnPf f0, f1, f2;
    attn_prefetch(f0, k8, v8, selb, 0, g, lane);
    if (nch > 1) attn_prefetch(f1, k8, v8, selb, 1, g, lane);
    if (nch > 2) attn_prefetch(f2, k8, v8, selb, 2, g, lane);
    for (int ch = 0; ch < nch; ch += 3) {
        attn_chunk<ONLINE>(f0, qf, ch, cnt, mb, m_run, l_run, o, vt, lane);
        if (ch + 3 < nch) attn_prefetch(f0, k8, v8, selb, ch + 3, g, lane);
        if (ch + 1 < nch) {
            attn_chunk<ONLINE>(f1, qf, ch + 1, cnt, mb, m_run, l_run, o, vt, lane);
            if (ch + 4 < nch) attn_prefetch(f1, k8, v8, selb, ch + 4, g, lane);
        }
        if (ch + 2 < nch) {
            attn_chunk<ONLINE>(f2, qf, ch + 2, cnt, mb, m_run, l_run, o, vt, lane);
            if (ch + 5 < nch) attn_prefetch(f2, k8, v8, selb, ch + 5, g, lane);
        }
    }
    if (!ONLINE) l_run = rows4_sum(l_run);
    const float l0 = __int_as_float(__builtin_amdgcn_readlane(__float_as_int(l_run), 0)), l1 = __int_as_float(__builtin_amdgcn_readlane(__float_as_int(l_run), 1)), l2 = __int_as_float(__builtin_amdgcn_readlane(__float_as_int(l_run), 2)), l3 = __int_as_float(__builtin_amdgcn_readlane(__float_as_int(l_run), 3));
    if (lane < 16) {
        bf16* ao = (bf16*)(ws + WS_AO) + (size_t)row * DM + (4 * g) * 128 + lane;
        const float i0 = 1.f / l0, i1 = 1.f / l1, i2 = 1.f / l2, i3 = 1.f / l3;
#pragma unroll
        for (int c = 0; c < 8; ++c) {
            ao[0 * 128 + 16 * c] = (bf16)(pk2(o[c][0] * i0, 0.f) & 0xffffu); ao[1 * 128 + 16 * c] = (bf16)(pk2(o[c][1] * i1, 0.f) & 0xffffu);
            ao[2 * 128 + 16 * c] = (bf16)(pk2(o[c][2] * i2, 0.f) & 0xffffu); ao[3 * 128 + 16 * c] = (bf16)(pk2(o[c][3] * i3, 0.f) & 0xffffu); }
    }
    LDS_WAIT();
}
template <bool ONLINE, bool GROUPED>
__device__ __forceinline__ void attn_prompt_loop(const Params& p, int j0, int stride, int njobs, int gfix, float mb, LAS unsigned char* vt, LAS int* selb, int lane) {
    unsigned char* ws = p.ws;
    if (j0 >= njobs) return;
    int row = GROUPED ? TP - 1 - j0 : TP - 1 - (j0 >> 2);
    int cnt = ((const int*)(ws + WS_CNT))[row]; v4u selv = *(const v4u*)((const int*)(ws + WS_SEL) + (size_t)row * 256 + 4 * lane);
    for (int j = j0; j < njobs; j += stride) {
        const int jn = j + stride;
        const int nrow = jn < njobs ? (GROUPED ? TP - 1 - jn : TP - 1 - (jn >> 2)) : -1;
        int ncnt = 0; v4u nselv = (v4u){0u, 0u, 0u, 0u};
        attn_job_prompt<ONLINE>(p, row, GROUPED ? gfix : (j & 3), mb, vt, selb, lane, cnt, selv, nrow, ncnt, nselv);
        row = nrow; cnt = ncnt; selv = nselv;
    }
}

__device__ __forceinline__ float wave_scan_incl(float v, int lane) {
    (void)lane;
#define DPP_FM(x, ctrl, rm) __int_as_float(__builtin_amdgcn_update_dpp(0, __float_as_int(x), (ctrl), (rm), 0xf, false))
    v += DPP_FM(v, 0x111, 0xf); v += DPP_FM(v, 0x112, 0xf); v += DPP_FM(v, 0x114, 0xf); v += DPP_FM(v, 0x118, 0xf);
    v += DPP_FM(v, 0x142, 0xa); v += DPP_FM(v, 0x143, 0xc);
#undef DPP_FM
    return v;
}
__device__ __forceinline__ bf16x8 scale_frag2(bf16x8 x, const LAS float* fl, const LAS float* fh) {
    const v4u w = __builtin_bit_cast(v4u, x); const f32x4 f0 = *(const LAS f32x4*)fl, f1 = *(const LAS f32x4*)fh;
    v4u o; o.x = pk2(bf_lo(w.x) * f0[0], bf_hi(w.x) * f0[1]); o.y = pk2(bf_lo(w.y) * f0[2], bf_hi(w.y) * f0[3]);
    o.z = pk2(bf_lo(w.z) * f1[0], bf_hi(w.z) * f1[1]); o.w = pk2(bf_lo(w.w) * f1[2], bf_hi(w.w) * f1[3]);
    return __builtin_bit_cast(bf16x8, o);
}
__device__ __forceinline__ bf16x8 scale_frag(bf16x8 x, const LAS float* f) {
    const v4u w = __builtin_bit_cast(v4u, x); const f32x4 f0 = *(const LAS f32x4*)f, f1 = *(const LAS f32x4*)(f + 4);
    v4u o; o.x = pk2(bf_lo(w.x) * f0[0], bf_hi(w.x) * f0[1]); o.y = pk2(bf_lo(w.y) * f0[2], bf_hi(w.y) * f0[3]);
    o.z = pk2(bf_lo(w.z) * f1[0], bf_hi(w.z) * f1[1]); o.w = pk2(bf_lo(w.w) * f1[2], bf_hi(w.w) * f1[3]);
    return __builtin_bit_cast(bf16x8, o);
}
__device__ __forceinline__ void ssd_chunk_state(const Params& p, int c, int h, LAS float* fa, int lane) {
    unsigned char* ws = p.ws;
    const int g = h >> 3, t0 = 128 * c, r = lane & 31, hh = lane >> 5;
    const float* dtb = (const float*)(ws + WS_DTB);
    const float a = -expf(p.in[17][h]);
    const float d0 = dtb[(size_t)(t0 + lane) * 64 + h], d1 = dtb[(size_t)(t0 + 64 + lane) * 64 + h];
    const float c0 = wave_scan_incl(d0 * a, lane), tot0 = __int_as_float(__builtin_amdgcn_readlane(__float_as_int(c0), 63));
    const float c1 = wave_scan_incl(d1 * a, lane) + tot0, last = __int_as_float(__builtin_amdgcn_readlane(__float_as_int(c1), 63));
    fa[lane] = d0 * __expf(last - c0); fa[64 + lane] = d1 * __expf(last - c1);
    if (lane == 0) ((float*)(ws + WS_CSL))[c * 64 + h] = last;
    LDS_WAIT();
    f32x16 acc[2][4];
#pragma unroll
    for (int a_ = 0; a_ < 2; ++a_)
#pragma unroll
        for (int b_ = 0; b_ < 4; ++b_)
#pragma unroll
            for (int i = 0; i < 16; ++i) acc[a_][b_][i] = 0.f;
    const bf16* xt = (const bf16*)(ws + WS_XT) + (size_t)(c * 64 + h) * 8192 + lane * 8;
    const bf16* bt = (const bf16*)(ws + WS_BT) + (size_t)(c * 8 + g) * 16384 + lane * 8;
    bf16x8 xr[2], br[4];
#pragma unroll
    for (int pt = 0; pt < 2; ++pt) xr[pt] = *(const bf16x8*)(xt + (pt * 8) * 512);
#pragma unroll
    for (int ct = 0; ct < 4; ++ct) br[ct] = *(const bf16x8*)(bt + (ct * 8) * 512);
#pragma unroll 1
    for (int ks = 0; ks < 8; ++ks) {
        bf16x8 af[2], bf_[4];
#pragma unroll
        for (int pt = 0; pt < 2; ++pt) af[pt] = scale_frag2(xr[pt], fa + 16 * ks + 4 * hh, fa + 16 * ks + 8 + 4 * hh);
#pragma unroll
        for (int ct = 0; ct < 4; ++ct) bf_[ct] = br[ct];
        const int kn = ks < 7 ? ks + 1 : 7;
#pragma unroll
        for (int pt = 0; pt < 2; ++pt) xr[pt] = *(const bf16x8*)(xt + (pt * 8 + kn) * 512);
#pragma unroll
        for (int ct = 0; ct < 4; ++ct) br[ct] = *(const bf16x8*)(bt + (ct * 8 + kn) * 512);
#pragma unroll
        for (int pt = 0; pt < 2; ++pt)
#pragma unroll
            for (int ct = 0; ct < 4; ++ct) acc[pt][ct] = MFMA32(af[pt], bf_[ct], acc[pt][ct]);
    }
    unsigned* cs = (unsigned*)(ws + WS_CS) + (size_t)(c * 64 + h) * 32 * 128;
#pragma unroll
    for (int pt = 0; pt < 2; ++pt)
#pragma unroll
        for (int ct = 0; ct < 4; ++ct)
#pragma unroll
            for (int i = 0; i < 16; i += 2) { const int pp = 32 * pt + (i & 3) + 8 * (i >> 2) + 4 * hh; cs[(size_t)(pp >> 1) * 128 + 32 * ct + r] = pk2(acc[pt][ct][i], acc[pt][ct][i + 1]); }
    LDS_WAIT();
}
__device__ __forceinline__ void ssd_state_scan(const Params& p, int gtid, int gthreads) {
    unsigned char* ws = p.ws;
    const float* csl = (const float*)(ws + WS_CSL);
    for (int e = gtid; e < 64 * 64 * 32; e += gthreads) {
        const int h = e >> 11, q = e & 2047, pp_ = (q >> 6) * 2, n_ = (q & 63) * 2;
        const v2u* cs = (const v2u*)(ws + WS_CS) + e;
        bf16* st = (bf16*)(ws + WS_STIN) + ((((size_t)h * 2 + (pp_ >> 5)) * 8 + (n_ >> 4)) * 64 + (pp_ & 31) + 32 * ((n_ >> 3) & 1)) * 8 + (n_ & 7);
        f32x4 cur = (f32x4){0.f, 0.f, 0.f, 0.f};
#pragma unroll 8
        for (int c = 0; c < 64; ++c) {
            const v2u t = cs[(size_t)c * 131072];
            *(unsigned*)(st + (size_t)c * 524288) = pk2(cur[0], cur[2]); *(unsigned*)(st + (size_t)c * 524288 + 8) = pk2(cur[1], cur[3]);
            const float dec = __expf(csl[c * 64 + h]);
            cur = cur * dec + (f32x4){bf_lo(t.x), bf_hi(t.x), bf_lo(t.y), bf_hi(t.y)};
        }
        float* o = p.out + O_SSP + ((size_t)h * 64 + pp_) * 128 + n_;
        *(f32x2*)o = (f32x2){cur[0], cur[2]}; *(f32x2*)(o + 128) = (f32x2){cur[1], cur[3]};
    }
}
__device__ __forceinline__ void ssd_output_unit(const Params& p, int c, int g, LAS float* wl  , LAS float* ex  , LAS float* ys  , int wave, int lane) {
    unsigned char* ws = p.ws;
    const int h = 8 * g + wave, t0 = 128 * c, r = lane & 31, hh = lane >> 5;
    const float* dtb = (const float*)(ws + WS_DTB);
    const float a = -expf(p.in[17][h]);
    {
        const float d0 = dtb[(size_t)(t0 + lane) * 64 + h], d1 = dtb[(size_t)(t0 + 64 + lane) * 64 + h];
        const float c0 = wave_scan_incl(d0 * a, lane), tot0 = __int_as_float(__builtin_amdgcn_readlane(__float_as_int(c0), 63));
        const float c1 = wave_scan_incl(d1 * a, lane) + tot0;
        wl[lane] = c0; wl[64 + lane] = c1; wl[128 + lane] = d0; wl[192 + lane] = d1;
        LDS_WAIT();
    }
    const bf16* crow = (const bf16*)(ws + WS_CROW) + (size_t)(c * 8 + g) * 16384 + lane * 8;
    const bf16* brow = (const bf16*)(ws + WS_BROW) + (size_t)(c * 8 + g) * 16384 + lane * 8;
    const bf16* stin = (const bf16*)(ws + WS_STIN) + (size_t)(c * 64 + h) * 8192 + lane * 8;
    const bf16* xt = (const bf16*)(ws + WS_XT) + (size_t)(c * 64 + h) * 8192 + lane * 8;
    const int erow = lane >> 1, ehalf = lane & 1;
    const bf16* zp = (const bf16*)(ws + WS_PROJ) + (size_t)(t0 + erow) * NIN + C_Z + h * 64 + 32 * ehalf;
    const float dsk = p.in[18][h];
    bf16* so = (bf16*)(ws + WS_SSMO) + (size_t)t0 * DI + h * 64;
#pragma unroll 1
    for (int li = 0; li < 4; ++li) {
        bf16x8 cf[8], nb[8]; v4u nx[2][2], zr[4];
        f32x16 Y[2];
        {
            bf16x8 sf[2][8];
#pragma unroll
            for (int kk = 0; kk < 8; ++kk) cf[kk] = *(const bf16x8*)(crow + (li * 8 + kk) * 512);
#pragma unroll
            for (int pt = 0; pt < 2; ++pt)
#pragma unroll
                for (int kk = 0; kk < 8; ++kk) sf[pt][kk] = *(const bf16x8*)(stin + (pt * 8 + kk) * 512);
#pragma unroll
            for (int pt = 0; pt < 2; ++pt)
#pragma unroll
                for (int i = 0; i < 16; ++i) Y[pt][i] = 0.f;
#pragma unroll
            for (int kk = 0; kk < 8; ++kk)
#pragma unroll
                for (int pt = 0; pt < 2; ++pt) Y[pt] = MFMA32(cf[kk], sf[pt][kk], Y[pt]);
        }
#pragma unroll
        for (int kk = 0; kk < 8; ++kk) nb[kk] = *(const bf16x8*)(brow + kk * 512);
#pragma unroll
        for (int q = 0; q < 4; ++q) zr[q] = *(const v4u*)(zp + (size_t)(32 * li) * NIN + 8 * q);
#pragma unroll
        for (int i = 0; i < 16; ++i) { const float e = __expf(wl[32 * li + (i & 3) + 8 * (i >> 2) + 4 * hh]); Y[0][i] *= e; Y[1][i] *= e; }
        const float csl_ = wl[32 * li + r];
        v4u xd[2][2];
#pragma unroll 1
        for (int si = 0; si <= li; ++si) {
#pragma unroll
            for (int st = 0; st < 2; ++st)
#pragma unroll
                for (int pt = 0; pt < 2; ++pt) nx[st][pt] = *(const v4u*)(xt + (pt * 8 + 2 * si + st) * 512);
            f32x16 X;
#pragma unroll
            for (int i = 0; i < 16; ++i) X[i] = 0.f;
#pragma unroll
            for (int kk = 0; kk < 8; ++kk) X = MFMA32(nb[kk], cf[kk], X);
            if (si < li) {
#pragma unroll
                for (int kk = 0; kk < 8; ++kk) nb[kk] = *(const bf16x8*)(brow + ((si + 1) * 8 + kk) * 512);
            }
#pragma unroll
            for (int i = 0; i < 16; ++i) { const int sl = 32 * si + (i & 3) + 8 * (i >> 2) + 4 * hh, ll = 32 * li + r;
                X[i] = (sl <= ll) ? X[i] * __expf(csl_ - wl[sl]) * wl[128 + sl] : 0.f; }
#pragma unroll
            for (int st = 0; st < 2; ++st) {
                v4u aw; aw.x = pk2(X[8 * st + 0], X[8 * st + 1]); aw.y = pk2(X[8 * st + 2], X[8 * st + 3]); aw.z = pk2(X[8 * st + 4], X[8 * st + 5]); aw.w = pk2(X[8 * st + 6], X[8 * st + 7]);
                const bf16x8 af = __builtin_bit_cast(bf16x8, aw);
#pragma unroll
                for (int pt = 0; pt < 2; ++pt) Y[pt] = MFMA32(af, __builtin_bit_cast(bf16x8, nx[st][pt]), Y[pt]);
            }
        }
#pragma unroll
        for (int st = 0; st < 2; ++st)
#pragma unroll
            for (int pt = 0; pt < 2; ++pt) xd[st][pt] = nx[st][pt];
#pragma unroll
        for (int pt = 0; pt < 2; ++pt)
#pragma unroll
            for (int q = 0; q < 4; ++q) {
                const unsigned xw0 = (q & 1) ? xd[q >> 1][pt].z : xd[q >> 1][pt].x, xw1 = (q & 1) ? xd[q >> 1][pt].w : xd[q >> 1][pt].y;
                const float xv[4] = {bf_lo(xw0), bf_hi(xw0), bf_lo(xw1), bf_hi(xw1)};
#pragma unroll
                for (int e = 0; e < 4; ++e) ys[(8 * q + 4 * hh + e) * 68 + 32 * pt + r] = Y[pt][4 * q + e] + dsk * xv[e];
            }
        LDS_WAIT();
        {
            float yv[32];
#pragma unroll
            for (int q = 0; q < 8; ++q) { const f32x4 t = *(const LAS f32x4*)(ys + erow * 68 + 32 * ehalf + 4 * q); yv[4 * q] = t[0]; yv[4 * q + 1] = t[1]; yv[4 * q + 2] = t[2]; yv[4 * q + 3] = t[3]; }
            float sq = 0.f; v4u ow[4];
#pragma unroll
            for (int q = 0; q < 4; ++q) {
                const unsigned zw[4] = {zr[q].x, zr[q].y, zr[q].z, zr[q].w}; unsigned o4[4];
#pragma unroll
                for (int j = 0; j < 4; ++j) { const float y0 = yv[8 * q + 2 * j] * siluf_(bf_lo(zw[j])), y1 = yv[8 * q + 2 * j + 1] * siluf_(bf_hi(zw[j])); sq += y0 * y0 + y1 * y1; o4[j] = pk2(y0, y1); }
                ow[q] = (v4u){o4[0], o4[1], o4[2], o4[3]};
            }
            sq = sum2(sq);
            if (ehalf == 0) ex[(32 * li + erow) * 8 + wave] = sq;
            bf16* q_ = so + (size_t)(32 * li + erow) * DI + 32 * ehalf;
#pragma unroll
            for (int q = 0; q < 4; ++q) *(v4u*)(q_ + 8 * q) = ow[q];
        }
        LDS_WAIT();
    }
    LDS_WAIT(); VM_WAIT();
    __syncthreads();
    {
        const int chn = lane & 7, rsb = lane >> 3;
        const f32x4 g0 = *(const f32x4*)(p.in[19] + h * 64 + 8 * chn), g1 = *(const f32x4*)(p.in[19] + h * 64 + 8 * chn + 4);
#pragma unroll 4
        for (int k = 0; k < 16; ++k) { const int l = rsb + 8 * k;
            const LAS f32x4* e4 = (const LAS f32x4*)(ex + l * 8); const f32x4 ea = e4[0], eb = e4[1];
            const float tot = ((ea[0] + ea[1]) + (ea[2] + ea[3])) + ((eb[0] + eb[1]) + (eb[2] + eb[3]));
            const float rs = rsqrtf(tot * (1.f / 512.f) + EPS);
            bf16* q = so + (size_t)l * DI + 8 * chn; const v4u w = *(const v4u*)q;
            v4u o; o.x = pk2(bf_lo(w.x) * rs * g0[0], bf_hi(w.x) * rs * g0[1]); o.y = pk2(bf_lo(w.y) * rs * g0[2], bf_hi(w.y) * rs * g0[3]);
            o.z = pk2(bf_lo(w.z) * rs * g1[0], bf_hi(w.z) * rs * g1[1]); o.w = pk2(bf_lo(w.w) * rs * g1[2], bf_hi(w.w) * rs * g1[3]);
            *(v4u*)q = o; }
    }
    __syncthreads();
}
__device__ __forceinline__ void ssd_sample_unit(const Params& p, int b, int g, LAS float* ex  , LAS bf16* xzl  , int wave, int lane) {
    unsigned char* ws = p.ws;
    const int h = 8 * g + wave, r0 = TP + 4 * b, pq = lane >> 4, nq = lane & 15;
    const float* dtb = (const float*)(ws + WS_DTB);
    const float a = -expf(p.in[17][h]);
    float dt[4], cs[4];
#pragma unroll
    for (int s = 0; s < 4; ++s) { dt[s] = dtb[(size_t)(r0 + s) * 64 + h]; cs[s] = dt[s] * a + (s ? cs[s - 1] : 0.f); }
    const bf16* xbs = (const bf16*)(ws + WS_XBS) + (size_t)(4 * b) * CONVD;
    {
        const int tid = wave * 64 + lane, row = tid >> 7, chn = (tid & 127) * 4;
        const v2u xv = *(const v2u*)(xbs + (size_t)row * CONVD + g * 512 + chn);
        const v2u zv = *(const v2u*)((const bf16*)(ws + WS_PROJ) + (size_t)(r0 + row) * NIN + C_Z + g * 512 + chn);
        *(LAS v2u*)(xzl + row * 512 + chn) = xv; *(LAS v2u*)(xzl + 2048 + row * 512 + chn) = zv;
    }
    float Bn[4][8], Cn[4][8];
#pragma unroll
    for (int s = 0; s < 4; ++s) {
        const bf16* bp = xbs + (size_t)s * CONVD + DI + g * 128 + 8 * nq; const bf16* cp = bp + 1024;
        const v4u b0 = *(const v4u*)bp, c0 = *(const v4u*)cp;
        const unsigned bw[4] = {b0.x, b0.y, b0.z, b0.w}, cw[4] = {c0.x, c0.y, c0.z, c0.w};
#pragma unroll
        for (int j = 0; j < 4; ++j) { Bn[s][2 * j] = bf_lo(bw[j]); Bn[s][2 * j + 1] = bf_hi(bw[j]); Cn[s][2 * j] = bf_lo(cw[j]); Cn[s][2 * j + 1] = bf_hi(cw[j]); }
    }
    float cbm[4][4];
#pragma unroll
    for (int l = 0; l < 4; ++l)
#pragma unroll
        for (int s = 0; s < 4; ++s) { float v = 0.f;
            if (s <= l) {
#pragma unroll
                for (int j = 0; j < 8; ++j) v += Cn[l][j] * Bn[s][j];
                v = sum16(v);
                v *= __expf(cs[l] - cs[s]) * dt[s]; }
            cbm[l][s] = v; }
    float ecs[4], fdec[4];
#pragma unroll
    for (int s = 0; s < 4; ++s) { ecs[s] = __expf(cs[s]); fdec[s] = dt[s] * __expf(cs[3] - cs[s]); }
    const float e3 = ecs[3], dsk = p.in[18][h];
    const float* sin_ = p.in[6] + ((size_t)(b * 64 + h) * 64) * 128 + 8 * nq;
    float* sout = p.out + O_SSS + ((size_t)(b * 64 + h) * 64) * 128 + 8 * nq;
    const bf16* zp = (const bf16*)(ws + WS_PROJ) + (size_t)r0 * NIN + C_Z + h * 64;
    float sq[4] = {0.f, 0.f, 0.f, 0.f};
    bf16* so = (bf16*)(ws + WS_SSMO) + (size_t)r0 * DI + h * 64;
    f32x4 S[4][2];
#pragma unroll
    for (int u = 0; u < 4; ++u)
#pragma unroll
        for (int q = 0; q < 2; ++q) S[u][q] = *(const f32x4*)(sin_ + (size_t)(pq + 4 * u) * 128 + 4 * q);
    LDS_WAIT();
    __syncthreads();
#pragma unroll 1
    for (int i0 = 0; i0 < 16; i0 += 4) {
        f32x4 Sn[4][2];
        const int inx = (i0 + 4 < 16) ? i0 + 4 : i0;
#pragma unroll
        for (int u = 0; u < 4; ++u)
#pragma unroll
            for (int q = 0; q < 2; ++q) Sn[u][q] = *(const f32x4*)(sin_ + (size_t)(pq + 4 * (inx + u)) * 128 + 4 * q);
#pragma unroll
        for (int u = 0; u < 4; ++u) {
            const int pp = pq + 4 * (i0 + u);
            float xs[4], xd[4];
#pragma unroll
            for (int s = 0; s < 4; ++s) { xs[s] = bf1(xzl[s * 512 + wave * 64 + pp]); xd[s] = xs[s] * fdec[s]; }
            float yo[4] = {0.f, 0.f, 0.f, 0.f};
#pragma unroll
            for (int q = 0; q < 2; ++q)
#pragma unroll
                for (int e = 0; e < 4; ++e) { const float sv = S[u][q][e]; const int j = 4 * q + e;
#pragma unroll
                    for (int l = 0; l < 4; ++l) yo[l] += Cn[l][j] * sv;
                    S[u][q][e] = e3 * sv + ((Bn[0][j] * xd[0] + Bn[1][j] * xd[1]) + (Bn[2][j] * xd[2] + Bn[3][j] * xd[3])); }
#pragma unroll
            for (int q = 0; q < 2; ++q) *(f32x4*)(sout + (size_t)pp * 128 + 4 * q) = S[u][q];
#pragma unroll
            for (int l = 0; l < 4; ++l) { float v = yo[l]; v = sum16(v);
                float yd = 0.f;
#pragma unroll
                for (int s = 0; s < 4; ++s) if (s <= l) yd += cbm[l][s] * xs[s];
                const float z = bf1(xzl[2048 + l * 512 + wave * 64 + pp]);
                const float y = (v * ecs[l] + yd + dsk * xs[l]) * siluf_(z);
                if (nq == 0) { sq[l] += y * y; so[(size_t)l * DI + pp] = (bf16)(pk2(y, 0.f) & 0xffffu); } }
        }
#pragma unroll
        for (int u = 0; u < 4; ++u)
#pragma unroll
            for (int q = 0; q < 2; ++q) S[u][q] = Sn[u][q];
    }
#pragma unroll
    for (int l = 0; l < 4; ++l) { const float s = wave_sum(sq[l]); if (lane == 0) ex[l * 8 + wave] = s; }
    LDS_WAIT(); VM_WAIT();
    __syncthreads();
    if (lane < 32) {
        const int l = lane >> 3, chn = lane & 7;
        float tot = 0.f;
#pragma unroll
        for (int w = 0; w < 8; ++w) tot += ex[l * 8 + w];
        const float rs = rsqrtf(tot * (1.f / 512.f) + EPS);
        const f32x4 g0 = *(const f32x4*)(p.in[19] + h * 64 + 8 * chn), g1 = *(const f32x4*)(p.in[19] + h * 64 + 8 * chn + 4);
        bf16* q = so + (size_t)l * DI + 8 * chn; const v4u w = *(const v4u*)q;
        v4u o; o.x = pk2(bf_lo(w.x) * rs * g0[0], bf_hi(w.x) * rs * g0[1]); o.y = pk2(bf_lo(w.y) * rs * g0[2], bf_hi(w.y) * rs * g0[3]);
        o.z = pk2(bf_lo(w.z) * rs * g1[0], bf_hi(w.z) * rs * g1[1]); o.w = pk2(bf_lo(w.w) * rs * g1[2], bf_hi(w.w) * rs * g1[3]);
        *(v4u*)q = o;
    }
    __syncthreads();
}

#ifndef ATTN_GROUPED
#define ATTN_GROUPED 0
#endif
#ifndef N_PHASES
#define N_PHASES 12
#endif
#ifndef ONE_LAUNCH
#define ONE_LAUNCH 1
#endif
__global__ void __launch_bounds__(NTHR, 2) fwd_kernel(Params p) {
    extern __shared__ __attribute__((aligned(16))) unsigned char lds_raw[];
    LAS unsigned char* lds = (LAS unsigned char*)lds_raw;
    const int wave = __builtin_amdgcn_readfirstlane((int)threadIdx.x >> 6);
#define LANE_ID() ({ int l_; asm volatile("v_mbcnt_lo_u32_b32 %0, -1, 0\n\tv_mbcnt_hi_u32_b32 %0, -1, %0" : "=v"(l_)); l_; })
    const int G = gridDim.x, blk = blockIdx.x;
    const int gw = blk * NWAVES + wave, ngw = G * NWAVES;
    unsigned char* ws = p.ws;
    volatile LAS unsigned* MISC = (volatile LAS unsigned*)(lds + MISC_OFF);
    { const int tid0 = wave * 64 + LANE_ID(); for (int u = tid0; u < (LDS_BYTES - CTL_OFF) / 4; u += NTHR) ((LAS unsigned*)(lds + CTL_OFF))[u] = 0u; }
    __syncthreads();
    XcdBarrier bar; bar.bar = (unsigned*)(ws + WS_CTL) + CW_BAR; bar.x = 0; bar.st = nullptr;
#if ONE_LAUNCH
    bar = xcd_barrier_post((unsigned*)(ws + WS_CTL) + CW_BAR, MISC + 8);
#endif
    float* const SSQP = (float*)(ws + WS_CTL + 262144);
    const int lo = p.ph_lo, hi = p.ph_hi;
#ifdef DIAG_A
    unsigned long long* stp = (unsigned long long*)(ws + WS_CTL + 65536);
#define STAMP(i) do { if (blk == 0 && threadIdx.x == 0) stp[i] = __builtin_amdgcn_s_memrealtime(); } while (0)
#else
#define STAMP(i) do { } while (0)
#endif
    STAMP(0);
#ifndef PH_MASK
#define PH_MASK 0xFFF
#endif
#define IN(k) (((PH_MASK >> (k)) & 1) && lo <= (k) && (k) < hi)
#ifndef BAR_REP
#define BAR_REP 1
#endif
#define SEAM(k) do { if (IN(k) && IN((k) + 1)) { _Pragma("unroll") for (int br_ = 0; br_ < BAR_REP; ++br_) xcd_barrier(bar); } } while (0)
#ifndef DBL_MASK
#define DBL_MASK 0
#endif
#define REP(b) _Pragma("unroll") for (int rep_ = 0; rep_ < (((DBL_MASK >> (b)) & 1) ? 2 : 1); ++rep_)

    if (IN(0)) { const int lane = LANE_ID(); REP(0) phase_prologue(p, lds, gw, ngw, wave, lane); }
    SEAM(0); STAMP(1);
    if (IN(1)) REP(1) {
        pg8::Gemm g{(const bf16*)(ws + WS_XN), (const bf16*)(ws + WS_WIN), MT, NIN, DM}; pg8::StaticOrder S; S.init(MT, NIN, G, blk);
        BigEpi<FIn> E{FIn{(bf16*)(ws + WS_PROJ), (float*)(ws + WS_PF)}, 0, nullptr};
        pg8::gemm_phase<BigEpi<FIn>, pg8::StaticOrder, true, true>(lds, g, S, E);
    }
    SEAM(1); STAMP(2);
    if (IN(2)) REP(2) {
        const int lane = LANE_ID();
        REP(15) {
            for (int r = gw; r < TP; r += ngw) p2_row(p, r, lane);
            if (ngw >= TS) { if (gw >= ngw - TS) p2_row(p, TP + gw - (ngw - TS), lane); } else for (int r = TP + gw; r < MT; r += ngw) p2_row(p, r, lane);
        }
        STAMP(23);
        REP(16) for (int u = gw; u < (TP / CONV_TOK) * 12; u += ngw) conv_unit_prompt(p, u, lds + wave * 16384, lane);
        for (int u = gw; u < NB * 12; u += ngw) conv_unit_sample(p, u, lane);
    }
    SEAM(2); STAMP(3);
    if (IN(3)) {
        const int lane = LANE_ID();
#ifndef P3S
#define P3S 15
#endif
        REP(3) if (P3S & 1) for (int u = blk; u < 2176; u += G) score_unit_prompt(p, 2175 - u, lds + 32768, wave, lane);
        REP(3) if (P3S & 2) {
            const int nheavy = 2176 % G, nlw = (G - nheavy) * NWAVES;
            if (nheavy == 0) { for (int j = gw; j < NB * 13; j += ngw) score_job_sample(p, j, lane); }
            else if (blk >= nheavy) { for (int j = (blk - nheavy) * NWAVES + wave; j < NB * 13; j += nlw) score_job_sample(p, j, lane); }
        }
        STAMP(20);
        REP(4) if (P3S & 4) for (int j = gw; j < 64 * 64; j += ngw) ssd_chunk_state(p, j >> 6, j & 63, (LAS float*)(lds + wave * 1024), lane);
        __syncthreads();
        STAMP(21);
        REP(5) if (P3S & 8) for (int u = blk; u < NB * 8; u += G) ssd_sample_unit(p, u >> 3, u & 7, (LAS float*)(lds + 16384), (LAS bf16*)(lds + 20480), wave, lane);
    }
    SEAM(3); STAMP(4);
    if (IN(4)) {
        const int lane = LANE_ID(); const int tid = wave * 64 + lane;
        LAS unsigned* hist = (LAS unsigned*)(lds + wave * 16768); LAS unsigned* ck = hist + 1024; LAS unsigned short* ci = (LAS unsigned short*)(hist + 1024 + CAND_CAP + 64);
        REP(6) for (int j = gw; j < TP; j += ngw) select_row<false>(p, TP - 1 - j, hist, ck, ci, lane);
        REP(6) for (int j = gw; j < TS; j += ngw) select_row<true>(p, TP + j, hist, ck, ci, lane);
        STAMP(24);
        REP(7) ssd_state_scan(p, blk * NTHR + tid, G * NTHR);
    }
    SEAM(4); STAMP(5);
    if (IN(5)) {
        const int lane = LANE_ID();
#ifndef P5S
#define P5S 7
#endif
        REP(8) if (P5S & 1) for (int u = blk; u < 64 * 8; u += G) ssd_output_unit(p, u >> 3, u & 7, (LAS float*)(lds + wave * 1024), (LAS float*)(lds + 8192), (LAS float*)(lds + 16384 + wave * 8704), wave, lane);
        __syncthreads();
        STAMP(22);
        LAS unsigned char* vt = lds + wave * 9216; LAS int* selb = (LAS int*)(vt + 8192);
        REP(9) if (P5S & 2) for (int j = gw; j < TS * 4; j += ngw) attn_job<true>(p, TP + (j >> 2), j & 3, vt, lane);
        {
            const int xcd = blk & 7, g = xcd & 3, nwq = (G >> 2) * NWAVES;
            const int wq = ((blk >> 3) * 2 + (xcd >> 2)) * NWAVES + wave;
            float gq = fmaxf(fabsf(p.in[10][lane]), fabsf(p.in[10][64 + lane])), gk = fmaxf(fabsf(p.in[11][lane]), fabsf(p.in[11][64 + lane]));
#pragma unroll
            for (int o_ = 1; o_ < 64; o_ <<= 1) { gq = fmaxf(gq, __shfl_xor(gq, o_)); gk = fmaxf(gk, __shfl_xor(gk, o_)); }
            const float mb = 1.1f * 11.313708499f * 1.4426950408889634f * gq * gk;
            const bool fixedb = __builtin_amdgcn_readfirstlane(mb < 40.f ? 1 : 0) != 0;
            if (fixedb) {
                if (ATTN_GROUPED && (G & 7) == 0) { REP(9) if (P5S & 4) attn_prompt_loop<false, true>(p, wq, nwq, TP, g, mb, vt, selb, lane); }
                else { REP(9) if (P5S & 4) attn_prompt_loop<false, false>(p, gw, ngw, TP * 4, 0, mb, vt, selb, lane); }
            } else {
                attn_prompt_loop<true, false>(p, gw, ngw, TP * 4, 0, mb, vt, selb, lane);
            }
        }
    }
    SEAM(5); STAMP(6);
    if (IN(6)) REP(10) {
        pg8::Gemm g{(const bf16*)(ws + WS_AO), (const bf16*)(ws + WS_WPA), TP, DM, DM}; pg8::StaticOrder S; S.init(TP, DM, G, blk);
        const FPA F{(const bf16*)(ws + WS_PROJ), (bf16*)(ws + WS_MIX32)};
        BigEpi<FPA> E{F, 0, nullptr};
        pg8::gemm_phase<BigEpi<FPA>, pg8::StaticOrder, true, true>(lds, g, S, E);
        { const int lane = LANE_ID(); gemm_small(lds, (const bf16*)(ws + WS_AO) + (size_t)TP * DM, (const bf16*)(ws + WS_WPA), TS, DM, DM, F, TP, SSQP, G, blk, wave, lane); }
    }
    if (IN(6) && IN(7)) { VM_WAIT(); __syncthreads(); }
    if (IN(7)) REP(10) {
        pg8::Gemm g{(const bf16*)(ws + WS_SSMO), (const bf16*)(ws + WS_WPS), TP, DM, DI}; pg8::StaticOrder S; S.init(TP, DM, G, blk);
        const FPS F{(const bf16*)(ws + WS_PROJ), (const bf16*)(ws + WS_MIX32), (bf16*)(ws + WS_MIXB)};
        BigEpi<FPS> E{F, 0, nullptr};
        pg8::gemm_phase<BigEpi<FPS>, pg8::StaticOrder, true, true>(lds, g, S, E);
        { const int lane = LANE_ID(); gemm_small(lds, (const bf16*)(ws + WS_SSMO) + (size_t)TP * DI, (const bf16*)(ws + WS_WPS), TS, DM, DI, F, TP, SSQP, G, blk, wave, lane); }
    }
    SEAM(7); STAMP(8);
    if (IN(8)) REP(11) {
        pg8::Gemm g{(const bf16*)(ws + WS_MIXB), (const bf16*)(ws + WS_WOUT), TP, DM, DM}; pg8::StaticOrder S; S.init(TP, DM, G, blk);
        const FRes<true> F{p.in[0], p.in[1], nullptr, nullptr, (bf16*)(ws + WS_H)};
        BigEpi<FRes<true>> E{F, 0, SSQP};
        pg8::gemm_phase<BigEpi<FRes<true>>, pg8::StaticOrder, true, true>(lds, g, S, E);
        { const int lane = LANE_ID(); gemm_small(lds, (const bf16*)(ws + WS_MIXB) + (size_t)TP * DM, (const bf16*)(ws + WS_WOUT), TS, DM, DM, F, TP, SSQP, G, blk, wave, lane); }
    }
    SEAM(8); STAMP(9);
    if (IN(10)) REP(13) {
        pg8::Gemm g{(const bf16*)(ws + WS_H), (const bf16*)(ws + WS_WUP), TP, DFF, DM}; pg8::StaticOrder S; S.init(TP, DFF, G, blk);
        const FUp F{(bf16*)(ws + WS_U), SSQP};
        BigEpi<FUp> E{F, 0, nullptr};
        pg8::gemm_phase<BigEpi<FUp>, pg8::StaticOrder, true, true>(lds, g, S, E);
        { const int lane = LANE_ID(); gemm_small(lds, (const bf16*)(ws + WS_H) + (size_t)TP * DM, (const bf16*)(ws + WS_WUP), TS, DFF, DM, F, TP, SSQP, G, blk, wave, lane); }
    }
    SEAM(10); STAMP(11);
    if (IN(11)) REP(14) {
        pg8::Gemm g{(const bf16*)(ws + WS_U), (const bf16*)(ws + WS_WDN), TP, DM, DFF}; pg8::StaticOrder S; S.init(TP, DM, G, blk);
        const FRes<false> F{nullptr, nullptr, (const bf16*)(ws + WS_H), p.out + O_Y, nullptr};
        BigEpi<FRes<false>> E{F, 0, nullptr};
        pg8::gemm_phase<BigEpi<FRes<false>>, pg8::StaticOrder, true, true>(lds, g, S, E);
        { const int lane = LANE_ID(); gemm_small(lds, (const bf16*)(ws + WS_U) + (size_t)TP * DFF, (const bf16*)(ws + WS_WDN), TS, DM, DFF, F, TP, SSQP, G, blk, wave, lane); }
    }
#ifdef DIAG_A
    STAMP(12);
    xcd_barrier(bar);
    if (blk == 0 && threadIdx.x == 0) {
        const int ia[20] = {0, 1, 2, 3, 4, 5, 6, 8, 9, 10, 11, 3, 20, 21, 5, 22, 2, 23, 4, 24};
        const int ib[20] = {1, 2, 3, 4, 5, 6, 8, 9, 10, 11, 12, 20, 21, 4, 22, 6, 23, 3, 24, 5};
        const float ta = (float)(stp[ib[DIAG_A]] - stp[ia[DIAG_A]]) * 0.01f, tb = (float)(stp[ib[DIAG_B]] - stp[ia[DIAG_B]]) * 0.01f;
        p.out[O_Y] = 10.f * ta; p.out[O_IKS] = tb;
    }
#endif
#undef IN
#undef SEAM
}

extern "C" void kernel_launch(void* const* d_in, const int* in_sizes, int n_in, void* d_out, int out_size, void* d_ws, size_t ws_size, hipStream_t stream) {
    static int grid = 0;
    if (grid == 0) {
        if (n_in != 26 || (size_t)out_size != O_END || ws_size < WS_END3) { fprintf(stderr, "kernel_launch: unexpected shapes (n_in %d out %d ws %zu)\n", n_in, out_size, ws_size); grid = -1; return; }
        int dev = 0, cus = 0, per_cu = 0;
        if (hipGetDevice(&dev) != hipSuccess || hipDeviceGetAttribute(&cus, hipDeviceAttributeMultiprocessorCount, dev) != hipSuccess) { grid = -1; return; }
        if (hipFuncSetAttribute((const void*)fwd_kernel, hipFuncAttributeMaxDynamicSharedMemorySize, LDS_BYTES) != hipSuccess) { fprintf(stderr, "kernel_launch: hipFuncSetAttribute failed\n"); grid = -1; return; }
        if (hipOccupancyMaxActiveBlocksPerMultiprocessor(&per_cu, (const void*)fwd_kernel, NTHR, LDS_BYTES) != hipSuccess || per_cu < 1) fprintf(stderr, "kernel_launch: occupancy query reports %d\n", per_cu);
        (void)hipGetLastError();
        grid = cus;
    }
    if (grid < 0) return;
    (void)hipMemsetAsync((char*)d_ws + WS_CTL, 0, CTL_ZERO_BYTES, stream);
    Params a{};
    for (int i = 0; i < 26; ++i) a.in[i] = (const float*)d_in[i];
    a.out = (float*)d_out; a.ws = (unsigned char*)d_ws;
#if ONE_LAUNCH
    a.ph_lo = 0; a.ph_hi = N_PHASES;
    hipLaunchKernelGGL(fwd_kernel, dim3(grid), dim3(NTHR), LDS_BYTES, stream, a);
#else
    for (int ph = 0; ph < N_PHASES; ++ph) { a.ph_lo = ph; a.ph_hi = ph + 1; hipLaunchKernelGGL(fwd_kernel, dim3(grid), dim3(NTHR), LDS_BYTES, stream, a); }
#endif
}
```
